# Optimizing an MI355X kernel written in HIP

```python
import jax, jax.numpy as jnp
from jax import lax
import numpy as np

D_MODEL = 1024
BATCH = 4
SEQ = 8192
DEPTH = 2

GRID_W = 64
CTX_LEN = 256
EPS = 1e-6
N_HEADS = 8
N_KV_HEADS = 2
HEAD_DIM = 64
ATTN_W = N_HEADS * HEAD_DIM
KV_W = N_KV_HEADS * HEAD_DIM
CONV_W = D_MODEL - ATTN_W
CONV_TAPS = 3
Q_BLOCK = 128
ROPE_THETA = 10000.0
AXIS_DIM = HEAD_DIM // 2
IN_SPLITS = (ATTN_W, ATTN_W + KV_W, ATTN_W + 2 * KV_W, ATTN_W + 2 * KV_W + CONV_W, ATTN_W + 2 * KV_W + 2 * CONV_W)
IN_W = ATTN_W + 2 * KV_W + 3 * CONV_W
CHUNK = 128
GM_W = D_MODEL
GM_GROUPS = 8
GM_GC = GM_W // GM_GROUPS
D_FF = 2816
N_EXPERTS = 8
TOP_K = 2
EXPERT_FF = 3584
N_EVEN = (DEPTH + 1) // 2
N_ODD = DEPTH // 2

kernel_name = "hybrid_dit_attn_conv_gmlp_moe"


def _rms_norm(x, g):
    xf = x.astype(jnp.float32)
    y = xf * lax.rsqrt(jnp.mean(xf * xf, axis=-1, keepdims=True) + EPS)
    return (y * g.astype(jnp.float32)).astype(x.dtype)


def _layer_norm(x, g, b):
    xf = x.astype(jnp.float32)
    mu = jnp.mean(xf, axis=-1, keepdims=True)
    var = jnp.mean(jnp.square(xf - mu), axis=-1, keepdims=True)
    y = (xf - mu) * lax.rsqrt(var + EPS)
    return (y * g.astype(jnp.float32) + b.astype(jnp.float32)).astype(x.dtype)


def _modulation(cond, w_mod, b_mod):
    return jnp.split(jax.nn.silu(cond) @ w_mod + b_mod, 6, axis=-1)


def _pre(x, g, shift, scale):
    return _rms_norm(x, g) * (1.0 + scale) + shift


def _axial_rope(n):
    rows = n // GRID_W
    r, col = jnp.meshgrid(jnp.arange(rows, dtype=jnp.float32), jnp.arange(GRID_W, dtype=jnp.float32), indexing="ij")
    inv = 1.0 / (ROPE_THETA ** (jnp.arange(0, AXIS_DIM, 2, dtype=jnp.float32) / AXIS_DIM))
    ang = jnp.concatenate([r.reshape(-1, 1) * inv, col.reshape(-1, 1) * inv], axis=-1)
    return jnp.cos(ang), jnp.sin(ang)


def _apply_rope(x, cos, sin):
    cos = cos[None, :, None, :].astype(x.dtype)
    sin = sin[None, :, None, :].astype(x.dtype)
    x1, x2 = jnp.split(x, 2, axis=-1)
    return jnp.concatenate([x1 * cos - x2 * sin, x2 * cos + x1 * sin], axis=-1)


def _block_attention(q, k, v):
    b, n, h, d = q.shape
    kvh = k.shape[2]
    g = h // kvh
    qb = q.reshape(b, n // Q_BLOCK, Q_BLOCK, kvh, g, d).transpose(1, 0, 2, 3, 4, 5)
    scale = d ** -0.5

    def one_block(qblk):
        s = jnp.einsum("bqkgd,bmkd->bkgqm", qblk, k).astype(jnp.float32) * scale
        p = jax.nn.softmax(s, axis=-1).astype(v.dtype)
        return jnp.einsum("bkgqm,bmkd->bqkgd", p, v)

    o = lax.map(one_block, qb)
    return o.transpose(1, 0, 2, 3, 4, 5).reshape(b, n, h * d)


def _short_conv(z, w_conv):
    zp = jnp.pad(z, ((0, 0), (1, 1), (0, 0)))
    return w_conv[0] * zp[:, :-2] + w_conv[1] * zp[:, 1:-1] + w_conv[2] * zp[:, 2:]


def _context_kv(hc, w_in, g_k):
    b, m, _ = hc.shape
    k, v = jnp.split(hc @ w_in[:, ATTN_W:ATTN_W + 2 * KV_W], 2, axis=-1)
    k = _rms_norm(k.reshape(b, m, N_KV_HEADS, HEAD_DIM), g_k)
    return k, v.reshape(b, m, N_KV_HEADS, HEAD_DIM)


def _attn_conv_mixer(h, w_in, g_q, g_k, w_conv, w_out, rope, ext_kv):
    b, n, _ = h.shape
    q, k, v, gate_b, gate_c, hv = jnp.split(h @ w_in, IN_SPLITS, axis=-1)
    q = _rms_norm(q.reshape(b, n, N_HEADS, HEAD_DIM), g_q)
    k = _rms_norm(k.reshape(b, n, N_KV_HEADS, HEAD_DIM), g_k)
    v = v.reshape(b, n, N_KV_HEADS, HEAD_DIM)
    if rope is not None:
        q = _apply_rope(q, *rope)
        k = jnp.concatenate([ext_kv[0], _apply_rope(k, *rope)], axis=1)
        v = jnp.concatenate([ext_kv[1], v], axis=1)
    attn = _block_attention(q, k, v)
    conv = gate_b * _short_conv(gate_c * hv, w_conv)
    return jnp.concatenate([attn, conv], axis=-1) @ w_out


def _chunk_gmlp(h, w_in, g_v, b_v, w_s, b_s, w_out):
    b, n, _ = h.shape
    u, v = jnp.split(jax.nn.gelu(h @ w_in), 2, axis=-1)
    v = _layer_norm(v, g_v, b_v).reshape(b, n // CHUNK, CHUNK, GM_GROUPS, GM_GC)
    s = jnp.einsum("gpq,bcqgd->bcpgd", w_s, v) + b_s.T[:, :, None]
    return (u * s.reshape(b, n, GM_W)) @ w_out


def _swiglu(h, w_gate, w_up, w_down):
    return (jax.nn.silu(h @ w_gate) * (h @ w_up)) @ w_down


def _moe_swiglu(h, w_router, b_router, w_gate, w_up, w_down):
    logits = (h @ w_router).astype(jnp.float32) + b_router.astype(jnp.float32)
    top_v, top_i = lax.top_k(logits, TOP_K)
    wts = jax.nn.softmax(top_v, axis=-1)
    gates = jnp.sum(jax.nn.one_hot(top_i, N_EXPERTS, dtype=jnp.float32) * wts[..., None], axis=-2).astype(h.dtype)
    out = jnp.zeros_like(h)
    for e in range(N_EXPERTS):
        out = out + gates[..., e:e + 1] * _swiglu(h, w_gate[e], w_up[e], w_down[e])
    return out


def setup_inputs(seed: int = 0) -> dict:
    key = jax.random.key(seed)
    ks = list(jax.random.split(key, 48))
    D = D_MODEL
    ne, no = N_EVEN, N_ODD

    def nrm(shape, scale):
        return jax.random.normal(ks.pop(), shape, jnp.float32) * scale

    def gain(shape):
        return 1.0 + nrm(shape, 0.1)

    return {
        "x": nrm((BATCH, SEQ, D), 1.0),
        "c": nrm((BATCH, D), 1.0),
        "ctx": nrm((BATCH, CTX_LEN, D), 1.0),
        "c_ctx": nrm((D,), 1.0),
        "e_w_mod": nrm((ne, D, 6 * D), 0.5 * D ** -0.5),
        "e_b_mod": nrm((ne, 6 * D), 0.02),
        "e_g_pre_mix": gain((ne, D)),
        "e_g_post_mix": gain((ne, D)),
        "e_w_in": nrm((ne, D, IN_W), D ** -0.5),
        "e_g_q": gain((ne, HEAD_DIM)),
        "e_g_k": gain((ne, HEAD_DIM)),
        "e_w_conv": nrm((ne, CONV_TAPS, CONV_W), 0.5),
        "e_w_out": nrm((ne, ATTN_W + CONV_W, D), (ATTN_W + CONV_W) ** -0.5),
        "e_g_pre_ffn": gain((ne, D)),
        "e_g_post_ffn": gain((ne, D)),
        "e_w_gate": nrm((ne, D, D_FF), D ** -0.5),
        "e_w_up": nrm((ne, D, D_FF), D ** -0.5),
        "e_w_down": nrm((ne, D_FF, D), D_FF ** -0.5),
        "o_w_mod": nrm((no, D, 6 * D), 0.5 * D ** -0.5),
        "o_b_mod": nrm((no, 6 * D), 0.02),
        "o_g_pre_mix": gain((no, D)),
        "o_g_post_mix": gain((no, D)),
        "o_w_in": nrm((no, D, 2 * GM_W), D ** -0.5),
        "o_g_v": gain((no, GM_W)),
        "o_b_v": nrm((no, GM_W), 0.02),
        "o_w_s": nrm((no, GM_GROUPS, CHUNK, CHUNK), 0.5 * CHUNK ** -0.5),
        "o_b_s": gain((no, GM_GROUPS, CHUNK)),
        "o_w_out": nrm((no, GM_W, D), GM_W ** -0.5),
        "o_g_pre_ffn": gain((no, D)),
        "o_g_post_ffn": gain((no, D)),
        "o_w_router": nrm((no, D, N_EXPERTS), D ** -0.5),
        "o_b_router": nrm((no, N_EXPERTS), 0.01),
        "o_w_gate": nrm((no, N_EXPERTS, D, EXPERT_FF), D ** -0.5),
        "o_w_up": nrm((no, N_EXPERTS, D, EXPERT_FF), D ** -0.5),
        "o_w_down": nrm((no, N_EXPERTS, EXPERT_FF, D), EXPERT_FF ** -0.5),
    }


def reference(x, c, ctx, c_ctx,
              e_w_mod, e_b_mod, e_g_pre_mix, e_g_post_mix, e_w_in, e_g_q, e_g_k, e_w_conv, e_w_out,
              e_g_pre_ffn, e_g_post_ffn, e_w_gate, e_w_up, e_w_down,
              o_w_mod, o_b_mod, o_g_pre_mix, o_g_post_mix, o_w_in, o_g_v, o_b_v, o_w_s, o_b_s, o_w_out,
              o_g_pre_ffn, o_g_post_ffn, o_w_router, o_b_router, o_w_gate, o_w_up, o_w_down):
    rope = _axial_rope(x.shape[1])
    for layer in range(DEPTH):
        i = layer // 2
        ctx_read_later = any(l % 2 == 0 for l in range(layer + 1, DEPTH))
        if layer % 2 == 0:
            mx = _modulation(c[:, None, :], e_w_mod[i], e_b_mod[i])
            mc = _modulation(c_ctx, e_w_mod[i], e_b_mod[i])
            hc = _pre(ctx, e_g_pre_mix[i], mc[0], mc[1])
            ctx_kv = _context_kv(hc, e_w_in[i], e_g_k[i])
            hx = _pre(x, e_g_pre_mix[i], mx[0], mx[1])
            y = _attn_conv_mixer(hx, e_w_in[i], e_g_q[i], e_g_k[i], e_w_conv[i], e_w_out[i], rope, ctx_kv)
            x = x + mx[2] * _rms_norm(y, e_g_post_mix[i])
            f = _swiglu(_pre(x, e_g_pre_ffn[i], mx[3], mx[4]), e_w_gate[i], e_w_up[i], e_w_down[i])
            x = x + mx[5] * _rms_norm(f, e_g_post_ffn[i])
            if ctx_read_later:
                yc = _attn_conv_mixer(hc, e_w_in[i], e_g_q[i], e_g_k[i], e_w_conv[i], e_w_out[i], None, None)
                ctx = ctx + mc[2] * _rms_norm(yc, e_g_post_mix[i])
                fc = _swiglu(_pre(ctx, e_g_pre_ffn[i], mc[3], mc[4]), e_w_gate[i], e_w_up[i], e_w_down[i])
                ctx = ctx + mc[5] * _rms_norm(fc, e_g_post_ffn[i])
        else:
            mx = _modulation(c[:, None, :], o_w_mod[i], o_b_mod[i])
            hx = _pre(x, o_g_pre_mix[i], mx[0], mx[1])
            y = _chunk_gmlp(hx, o_w_in[i], o_g_v[i], o_b_v[i], o_w_s[i], o_b_s[i], o_w_out[i])
            x = x + mx[2] * _rms_norm(y, o_g_post_mix[i])
            f = _moe_swiglu(_pre(x, o_g_pre_ffn[i], mx[3], mx[4]), o_w_router[i], o_b_router[i],
                            o_w_gate[i], o_w_up[i], o_w_down[i])
            x = x + mx[5] * _rms_norm(f, o_g_post_ffn[i])
            if ctx_read_later:
                mc = _modulation(c_ctx, o_w_mod[i], o_b_mod[i])
                hc = _pre(ctx, o_g_pre_mix[i], mc[0], mc[1])
                yc = _chunk_gmlp(hc, o_w_in[i], o_g_v[i], o_b_v[i], o_w_s[i], o_b_s[i], o_w_out[i])
                ctx = ctx + mc[2] * _rms_norm(yc, o_g_post_mix[i])
                fc = _moe_swiglu(_pre(ctx, o_g_pre_ffn[i], mc[3], mc[4]), o_w_router[i], o_b_router[i],
                                 o_w_gate[i], o_w_up[i], o_w_down[i])
                ctx = ctx + mc[5] * _rms_norm(fc, o_g_post_ffn[i])
    return x
```

```cpp
#include <hip/hip_runtime.h>
#include <cstdio>
#include <cstdint>
namespace pg8 {
#define PG8_LAS __attribute__((address_space(3)))
typedef unsigned short bf16_t;
typedef short bf16x8 __attribute__((ext_vector_type(8)));
typedef float f32x4 __attribute__((ext_vector_type(4)));
typedef unsigned u32x4 __attribute__((ext_vector_type(4)));
constexpr int BM = 256, BK = 64, HALF = 128, HTB = HALF * BK * 2  , STAGE_BYTES = 8 * HTB, NXCD = 8, WGM = 8;

__host__ __device__ __forceinline__ int lds_byte(int r, int c) { const int st = (r >> 4) * 2 + (c >> 5), rr = r & 15, cc = c & 31, ob = rr * 64 + cc * 2; return st * 1024 + (ob ^ (((ob >> 9) & 1) << 5)); }
__host__ __device__ __forceinline__ void stage_rc(int b, int& R, int& C) { const int st = b / 1024, sb = b % 1024, swz = sb ^ (((sb >> 9) & 1) << 5); R = (st >> 1) * 16 + swz / 64; C = (st & 1) * 32 + (swz % 64) / 2; }
__host__ __device__ __forceinline__ int perm32(int rho) { const int n = rho >> 4, i = rho & 15; return 8 * (i >> 2) + 4 * n + (i & 3); }

struct Unit { int pm, pn; };
struct Gemm { const bf16_t* A; const bf16_t* Bt; int M, N, K; };

struct StaticOrder {
    int nM, nN, nwg, G, c;
    __host__ __device__ void init(int M, int N, int G_, int c_) { nM = M / BM; nN = N / BM; nwg = nM * nN; G = G_; c = c_; }
    __host__ __device__ bool next(int i, Unit& u) const {
        const long L = (long)i * G + c; if (L >= nwg) return false;
        int wgid = (int)L; { const int q = nwg / NXCD, r = nwg % NXCD, xcd = wgid % NXCD, off = wgid / NXCD; wgid = (xcd < r ? xcd * (q + 1) : r * (q + 1) + (xcd - r) * q) + off; }
        const int nig = WGM * nN, gid = wgid / nig, fm = gid * WGM, gsz = (nM - fm) < WGM ? (nM - fm) : WGM;
        u.pm = fm + ((wgid % nig) % gsz); u.pn = (wgid % nig) / gsz; return true;
    }
    __device__ __forceinline__ void a_ready(const Unit&) const {}
    __device__ __forceinline__ void done(const Unit&) const {}
};


__device__ __forceinline__ void map_tile(int L, int nM, int nN, int& pm, int& pn) {
    const int nwg = nM * nN; int wgid = L;
    { const int q = nwg / NXCD, r = nwg % NXCD, xcd = wgid % NXCD, off = wgid / NXCD; wgid = (xcd < r ? xcd * (q + 1) : r * (q + 1) + (xcd - r) * q) + off; }
    const int nig = WGM * nN, gid = wgid / nig, fm = gid * WGM, gsz = (nM - fm) < WGM ? (nM - fm) : WGM;
    pm = fm + ((wgid % nig) % gsz); pn = (wgid % nig) / gsz;
}

__device__ __forceinline__ unsigned cvt_pk_bf16(float lo, float hi) { unsigned r; asm volatile("v_cvt_pk_bf16_f32 %0, %1, %2" : "=v"(r) : "v"(lo), "v"(hi)); return r; }

__device__ __forceinline__ float gelu_tanh_f(float x) {
    const float z2 = x * (1.5957691216f + 0.0713548163f * x * x);
    return x * __builtin_amdgcn_rcpf(1.0f + __builtin_amdgcn_exp2f(-1.4426950409f * z2));
}
__device__ __forceinline__ float silu_f(float x) { return x * __builtin_amdgcn_rcpf(1.0f + __builtin_amdgcn_exp2f(-1.4426950409f * x)); }

template <int ACT> struct EpiBf16 {
    static constexpr bool PERM = true, AFTER_DRAIN = false;
    bf16_t* O; int ldc; int pn_mod; int rowoff;
    __device__ __forceinline__ void operator()(const f32x4 (&acc)[2][2][4][2], const Unit& u, int wr, int wc, int fr, int fq) const {
        const int row0 = rowoff + u.pm * BM + wr * 64 + fr; const int colt = (pn_mod ? (u.pn % pn_mod) : u.pn) * BM;
        const int col0 = colt + wc * 32 + 8 * fq;
#pragma unroll
        for (int ai = 0; ai < 2; ++ai)
#pragma unroll
            for (int m = 0; m < 4; ++m) { bf16_t* rowp = O + (size_t)(row0 + ai * HALF + m * 16) * ldc + col0;
#pragma unroll
                for (int bj = 0; bj < 2; ++bj) { f32x4 v0 = acc[ai][bj][m][0], v1 = acc[ai][bj][m][1];
                    if (ACT == 1) { v0 = (f32x4){gelu_tanh_f(v0[0]), gelu_tanh_f(v0[1]), gelu_tanh_f(v0[2]), gelu_tanh_f(v0[3])}; v1 = (f32x4){gelu_tanh_f(v1[0]), gelu_tanh_f(v1[1]), gelu_tanh_f(v1[2]), gelu_tanh_f(v1[3])}; }
                    u32x4 w; w.x = cvt_pk_bf16(v0[0], v0[1]); w.y = cvt_pk_bf16(v0[2], v0[3]); w.z = cvt_pk_bf16(v1[0], v1[1]); w.w = cvt_pk_bf16(v1[2], v1[3]);
                    *(u32x4*)(rowp + bj * HALF) = w; } }
    }
};
struct EpiSwiGLU {
    static constexpr bool PERM = true, AFTER_DRAIN = false;
    bf16_t* O; int ldc; int pn_mod; int rowoff;
    __device__ __forceinline__ void operator()(const f32x4 (&acc)[2][2][4][2], const Unit& u, int wr, int wc, int fr, int fq) const {
        const int row0 = rowoff + u.pm * BM + wr * 64 + fr; const int colt = (pn_mod ? (u.pn % pn_mod) : u.pn) * HALF;
        const int col0 = colt + wc * 32 + 8 * fq;
#pragma unroll
        for (int ai = 0; ai < 2; ++ai)
#pragma unroll
            for (int m = 0; m < 4; ++m) { bf16_t* rowp = O + (size_t)(row0 + ai * HALF + m * 16) * ldc + col0;
                const f32x4 g0 = acc[ai][0][m][0], g1 = acc[ai][0][m][1], u0 = acc[ai][1][m][0], u1 = acc[ai][1][m][1];
                u32x4 w; w.x = cvt_pk_bf16(silu_f(g0[0]) * u0[0], silu_f(g0[1]) * u0[1]); w.y = cvt_pk_bf16(silu_f(g0[2]) * u0[2], silu_f(g0[3]) * u0[3]);
                w.z = cvt_pk_bf16(silu_f(g1[0]) * u1[0], silu_f(g1[1]) * u1[1]); w.w = cvt_pk_bf16(silu_f(g1[2]) * u1[2], silu_f(g1[3]) * u1[3]);
                *(u32x4*)rowp = w; }
    }
};
struct EpiGeluT {
    static constexpr bool PERM = false, AFTER_DRAIN = false;
    bf16_t* VT; int nch;
    __device__ __forceinline__ void operator()(const f32x4 (&acc)[2][2][4][2], const Unit& u, int wr, int wc, int fr, int fq) const {
        typedef unsigned u32x2v __attribute__((ext_vector_type(2)));
#pragma unroll
        for (int ai = 0; ai < 2; ++ai) { const int chunk = 2 * u.pm + ai;
#pragma unroll
            for (int bj = 0; bj < 2; ++bj)
#pragma unroll
                for (int n = 0; n < 2; ++n) { const int ch = u.pn * BM + bj * HALF + wc * 32 + n * 16 + fr; bf16_t* cp = VT + ((size_t)chunk * nch + ch) * 128 + wr * 64 + 4 * fq;
#pragma unroll
                    for (int m = 0; m < 4; ++m) { const f32x4 v = acc[ai][bj][m][n]; u32x2v w; w.x = cvt_pk_bf16(gelu_tanh_f(v[0]), gelu_tanh_f(v[1])); w.y = cvt_pk_bf16(gelu_tanh_f(v[2]), gelu_tanh_f(v[3]));
                        *(u32x2v*)(cp + m * 16) = w; } } }
    }
};


struct GridOrder {
    int nM, nN, G, c;
    __device__ __forceinline__ bool next(int i, Unit& u) const { const int L = i * G + c; if (L >= nM * nN) return false; map_tile(L, nM, nN, u.pm, u.pn); return true; }
    __device__ __forceinline__ void a_ready(const Unit&) const {}
    __device__ __forceinline__ void done(const Unit&) const {}
};
struct InProjOrder {
    int nM, nN, nX, pnX, G, c;
    __device__ __forceinline__ bool next(int i, Unit& u) const { const int L = i * G + c, n0 = nM * nN; if (L < n0) { map_tile(L, nM, nN, u.pm, u.pn); return true; } if (L < n0 + nX) { u.pm = nM + (L - n0); u.pn = pnX; return true; } return false; }
    __device__ __forceinline__ void a_ready(const Unit&) const {}
    __device__ __forceinline__ void done(const Unit&) const {}
};
struct MoeOrder {
    int nM, nN, G, c, tile0; const PG8_LAS int* tile_e;
    __device__ __forceinline__ bool next(int i, Unit& u) const { const int L = i * G + c; if (L >= nM * nN) return false; int pm, pn; map_tile(L, nM, nN, pm, pn); u.pm = pm; u.pn = tile_e[tile0 + pm] * nN + pn; return true; }
    __device__ __forceinline__ void a_ready(const Unit&) const {}
    __device__ __forceinline__ void done(const Unit&) const {}
};
template <class Epi, class Sched, bool ALIGN_EPI, bool SWAP, bool GATHER>
__device__ __forceinline__ void gemm_phase(PG8_LAS unsigned char* lds, const Gemm g, const Sched& S, const Epi& E, const PG8_LAS int* idxtab) {
    const int tid = threadIdx.x, wid = __builtin_amdgcn_readfirstlane(tid >> 6), lane = tid & 63, wr = wid >> 2, wc = wid & 3, fr = lane & 15, fq = lane >> 4;
    const int K = g.K, nt = K / BK;
    unsigned voffB[2], vc0[2], vc1[2], vn0[2], vn1[2]; int RA[2], CA[2];
#pragma unroll
    for (int i = 0; i < 2; ++i) { int R, C; stage_rc(tid * 16 + i * 8192, R, C); const int Rb = Epi::PERM ? ((R & ~31) + perm32(R & 31)) : R;
        RA[i] = R; CA[i] = C; voffB[i] = (unsigned)(Rb * K + C) * 2u; vc0[i] = vc1[i] = vn0[i] = vn1[i] = (unsigned)(R * K + C) * 2u; }
    const size_t kstep = (size_t)(BK * 2);
    const size_t hstep = (size_t)HALF * K * 2;
    const size_t tstep = 2 * hstep;
    const size_t hstepA = GATHER ? (size_t)0 : hstep;
    const unsigned ldsw = (unsigned)wid * 1024u;
    const int aoff = lds_byte(wr * 64 + fr, fq * 8), boff = lds_byte(wc * 32 + fr, fq * 8);
#define PG8_SA(b, h) (((b) * 2 + (h)) * HTB)
#define PG8_SB(b, h) ((4 + (b) * 2 + (h)) * HTB)
#define PG8_STAGE(bufoff, gbase, voff) do { _Pragma("unroll") for (int _i = 0; _i < 2; ++_i) \
        __builtin_amdgcn_global_load_lds((const unsigned*)((const char*)(gbase) + (voff)[_i]), (PG8_LAS unsigned*)(lds + (bufoff) + ldsw + _i * 8192), 16, 0, 0); } while (0)
#define PG8_LDA(dst, b, h) do { _Pragma("unroll") for (int m = 0; m < 4; ++m) _Pragma("unroll") for (int k = 0; k < 2; ++k) dst[m][k] = *(const PG8_LAS bf16x8*)(lds + PG8_SA(b, h) + aoff + m * 2048 + k * 1024); } while (0)
#define PG8_LDB(dst, b, h) do { _Pragma("unroll") for (int n = 0; n < 2; ++n) _Pragma("unroll") for (int k = 0; k < 2; ++k) dst[n][k] = *(const PG8_LAS bf16x8*)(lds + PG8_SB(b, h) + boff + n * 2048 + k * 1024); } while (0)
#define PG8_MMA(ai, bj, At, Bt) do { __builtin_amdgcn_s_setprio(1); _Pragma("unroll") for (int m = 0; m < 4; ++m) _Pragma("unroll") for (int n = 0; n < 2; ++n) _Pragma("unroll") for (int k = 0; k < 2; ++k) \
        acc[ai][bj][m][n] = SWAP ? __builtin_amdgcn_mfma_f32_16x16x32_bf16(At[m][k], Bt[n][k], acc[ai][bj][m][n], 0, 0, 0) : __builtin_amdgcn_mfma_f32_16x16x32_bf16(Bt[n][k], At[m][k], acc[ai][bj][m][n], 0, 0, 0); __builtin_amdgcn_s_setprio(0); } while (0)
#define PG8_WAIT_V(n) asm volatile("s_waitcnt vmcnt(" #n ")" ::: "memory")
#define PG8_WAIT_L(n) asm volatile("s_waitcnt lgkmcnt(" #n ")" ::: "memory")
#define PG8_BAR __builtin_amdgcn_s_barrier()
#define PG8_SCHED __builtin_amdgcn_sched_barrier(0)
    Unit cur, nxt; int ui = 0;
    if (!S.next(0, cur)) return;
    if constexpr (GATHER) {
#pragma unroll
        for (int i = 0; i < 2; ++i) { vc0[i] = (unsigned)(idxtab[RA[i]] * K + CA[i]) * 2u; vc1[i] = (unsigned)(idxtab[HALF + RA[i]] * K + CA[i]) * 2u; vn0[i] = vc0[i]; vn1[i] = vc1[i]; }
    }
    f32x4 acc[2][2][4][2];
#pragma unroll
    for (int a = 0; a < 2; ++a)
#pragma unroll
        for (int b = 0; b < 2; ++b)
#pragma unroll
            for (int m = 0; m < 4; ++m)
#pragma unroll
                for (int n = 0; n < 2; ++n) acc[a][b][m][n] = (f32x4){0.f, 0.f, 0.f, 0.f};
    bf16x8 At[4][2], B0[2][2], B1[2][2];
    const char* cA = GATHER ? (const char*)g.A : (const char*)g.A + (size_t)cur.pm * tstep; const char* cB = (const char*)g.Bt + (size_t)cur.pn * tstep;
    S.a_ready(cur);
    PG8_STAGE(PG8_SB(0, 0), cB, voffB); PG8_STAGE(PG8_SB(0, 1), cB + hstep, voffB); PG8_STAGE(PG8_SA(0, 0), cA, vc0); PG8_STAGE(PG8_SA(0, 1), cA + hstepA, vc1);
    if (wr == 1) PG8_BAR;
    PG8_WAIT_V(2); PG8_BAR;
    PG8_STAGE(PG8_SB(1, 0), cB + kstep, voffB); PG8_STAGE(PG8_SA(1, 0), cA + kstep, vc0); PG8_STAGE(PG8_SB(1, 1), cB + hstep + kstep, voffB);
    PG8_WAIT_V(6); PG8_BAR;
    for (;;) {
        const bool has_next = S.next(ui + 1, nxt);
        if constexpr (GATHER) {
            if (has_next) {
#pragma unroll
                for (int i = 0; i < 2; ++i) { vn0[i] = (unsigned)(idxtab[(ui + 1) * BM + RA[i]] * K + CA[i]) * 2u; vn1[i] = (unsigned)(idxtab[(ui + 1) * BM + HALF + RA[i]] * K + CA[i]) * 2u; }
            }
        }
        const char* nA = GATHER ? cA : (has_next ? (const char*)g.A + (size_t)nxt.pm * tstep : cA); const char* nB = has_next ? (const char*)g.Bt + (size_t)nxt.pn * tstep : cB;
        for (int t = 0; t < nt; t += 2) {
            const bool last = (t == nt - 2);
            const char* a1 = cA + (size_t)(t + 1) * kstep;
            const char* a2 = last ? nA : cA + (size_t)(t + 2) * kstep; const char* b2 = last ? nB : cB + (size_t)(t + 2) * kstep;
            const char* a3 = a2 + kstep; const char* b3 = b2 + kstep;
            unsigned w0[2], w1[2];
#pragma unroll
            for (int i = 0; i < 2; ++i) { w0[i] = (GATHER && last) ? vn0[i] : vc0[i]; w1[i] = (GATHER && last) ? vn1[i] : vc1[i]; }
            if (last && has_next) S.a_ready(nxt);
            PG8_LDB(B0, 0, 0); PG8_LDB(B1, 0, 1); PG8_SCHED; PG8_LDA(At, 0, 0); PG8_STAGE(PG8_SA(1, 1), a1 + hstepA, vc1);
            PG8_WAIT_V(8); PG8_WAIT_L(0); PG8_BAR; PG8_MMA(0, 0, At, B0); PG8_MMA(0, 1, At, B1); PG8_BAR; PG8_SCHED;
            PG8_LDA(At, 0, 1); PG8_STAGE(PG8_SB(0, 0), b2, voffB); PG8_STAGE(PG8_SB(0, 1), b2 + hstep, voffB); PG8_STAGE(PG8_SA(0, 0), a2, w0);
            PG8_WAIT_V(8); PG8_WAIT_L(0); PG8_BAR; PG8_MMA(1, 0, At, B0); PG8_MMA(1, 1, At, B1); PG8_BAR; PG8_SCHED;
            PG8_LDB(B0, 1, 0); PG8_LDB(B1, 1, 1); PG8_SCHED; PG8_LDA(At, 1, 0); PG8_STAGE(PG8_SA(0, 1), a2 + hstepA, w1);
            PG8_WAIT_V(8); PG8_WAIT_L(0); PG8_BAR; PG8_MMA(0, 0, At, B0); PG8_MMA(0, 1, At, B1); PG8_BAR; PG8_SCHED;
            PG8_LDA(At, 1, 1); PG8_STAGE(PG8_SB(1, 0), b3, voffB); PG8_STAGE(PG8_SB(1, 1), b3 + hstep, voffB); PG8_STAGE(PG8_SA(1, 0), a3, w0);
            PG8_WAIT_V(8); PG8_WAIT_L(0); PG8_BAR; PG8_MMA(1, 0, At, B0); PG8_MMA(1, 1, At, B1); PG8_BAR; PG8_SCHED;
        }
        if constexpr (ALIGN_EPI) { if (wr == 0) PG8_BAR; }
        E(acc, cur, wr, wc, fr, fq); S.done(cur);
        if (!has_next) break;
#pragma unroll
        for (int a = 0; a < 2; ++a)
#pragma unroll
            for (int b = 0; b < 2; ++b)
#pragma unroll
                for (int m = 0; m < 4; ++m)
#pragma unroll
                    for (int n = 0; n < 2; ++n) acc[a][b][m][n] = (f32x4){0.f, 0.f, 0.f, 0.f};
        cur = nxt; cA = nA; cB = nB; ++ui;
#pragma unroll
        for (int i = 0; i < 2; ++i) { vc0[i] = vn0[i]; vc1[i] = vn1[i]; }
        if constexpr (ALIGN_EPI) { if (wr == 1) PG8_BAR; }
    }
    PG8_WAIT_V(0);
    if constexpr (!ALIGN_EPI) { if (wr == 0) PG8_BAR; }
    PG8_BAR;
#undef PG8_SA
#undef PG8_SB
#undef PG8_STAGE
#undef PG8_LDA
#undef PG8_LDB
#undef PG8_MMA
#undef PG8_WAIT_V
#undef PG8_WAIT_L
#undef PG8_BAR
#undef PG8_SCHED
}
}
#include <hip/hip_bf16.h>
#include <cmath>
namespace attn_body {
using bf16=__hip_bfloat16;
using bf16x8=__attribute__((ext_vector_type(8)))short;
using s16x4=__attribute__((ext_vector_type(4)))short;
using f32x16=__attribute__((ext_vector_type(16)))float;
using u32x4=__attribute__((ext_vector_type(4)))unsigned;
constexpr int NHEAD=8,NKVH=2,SEQ=8192,SKV=8448,D=64,QP=512,KP=128,OP=1024;
constexpr int NW=8,QBLK=32,QB=QBLK*NW,KVBLK=64,NQB=SEQ/QB,NT=SKV/KVBLK;
constexpr int ATTN_UNIT_ROWS=QB;
__device__ __forceinline__ int crow(int r,int hi){return (r&3)+8*(r>>2)+4*hi;}
#define SBAR() __builtin_amdgcn_sched_barrier(0)
__device__ __forceinline__ void cmask(f32x16&p0,f32x16&p1,int jb,int qrel,int hi){
  const float NEG=-INFINITY; int kb=64*jb+4*hi;
  #pragma unroll
  for(int r=0;r<16;++r){int kv=kb+(r&3)+8*(r>>2); if(kv>qrel)p0[r]=NEG; if(kv+32>qrel)p1[r]=NEG;}
}

constexpr int NSLOT=3, SLOTB=8192;
constexpr int LDS_K=0, LDS_V=NSLOT*SLOTB, LDS_WS=2*NSLOT*SLOTB, LDS_OST=LDS_WS+NW*64*4, LDS_BYTES=LDS_OST+NW*4096;
constexpr float C2=0.125f*1.4426950408889634f;
__device__ __forceinline__ void glds16(const void*gsrc,unsigned lds_dst){unsigned keep;
  asm volatile("s_mov_b32 %0, m0\n\ts_mov_b32 m0, %2\n\ts_nop 0\n\tglobal_load_lds_dwordx4 %1, off\n\ts_mov_b32 m0, %0":"=&s"(keep):"v"(gsrc),"s"(lds_dst):"memory");}
__device__ __forceinline__ float max3f(float a,float b,float c){float r;asm("v_max3_f32 %0, %1, %2, %3":"=v"(r):"v"(a),"v"(b),"v"(c));return r;}
__device__ __forceinline__ float max2f(float a,float b){float r;asm("v_max_f32_e32 %0, %1, %2":"=v"(r):"v"(a),"v"(b));return r;}
__device__ __forceinline__ float fadd_s(float a,float b){float r;asm("v_add_f32_e32 %0, %1, %2":"=v"(r):"v"(a),"v"(b));return r;}
__device__ __forceinline__ float fsub_s(float a,float b){float r;asm("v_sub_f32_e32 %0, %1, %2":"=v"(r):"v"(a),"v"(b));return r;}
typedef float f32x2_t __attribute__((ext_vector_type(2))); typedef __bf16 bf16x2_t __attribute__((ext_vector_type(2)));
__device__ __forceinline__ unsigned cvtpk_s(float lo,float hi){f32x2_t v={lo,hi};bf16x2_t b=__builtin_convertvector(v,bf16x2_t);return __builtin_bit_cast(unsigned,b);}
#define WAIT_BAR(N) asm volatile("s_waitcnt vmcnt(" #N ") lgkmcnt(0)\n\ts_barrier":::"memory")

__device__ __forceinline__ void qkt(f32x16&p0,f32x16&p1,const char*Kslot,const bf16x8*qr,const f32x16&negm,int r32,int hi){
  const char*kb=Kslot+hi*1024+r32*16;
  #pragma unroll
  for(int d0=0;d0<4;++d0){
    const bf16x8 b0=*reinterpret_cast<const bf16x8*>(kb+d0*2048);
    const bf16x8 b1=*reinterpret_cast<const bf16x8*>(kb+d0*2048+512);
    if(d0==0){p0=__builtin_amdgcn_mfma_f32_32x32x16_bf16(b0,qr[0],negm,0,0,0);p1=__builtin_amdgcn_mfma_f32_32x32x16_bf16(b1,qr[0],negm,0,0,0);}
    else{p0=__builtin_amdgcn_mfma_f32_32x32x16_bf16(b0,qr[d0],p0,0,0,0);p1=__builtin_amdgcn_mfma_f32_32x32x16_bf16(b1,qr[d0],p1,0,0,0);}}
}
typedef __attribute__((address_space(3))) const char* lds_cptr;
typedef short v4i16_t __attribute__((ext_vector_type(4)));
__device__ __forceinline__ void kload8(bf16x8*kf,lds_cptr kp){
  kf[0]=*(const __attribute__((address_space(3))) bf16x8*)(kp);      kf[1]=*(const __attribute__((address_space(3))) bf16x8*)(kp+512);
  kf[2]=*(const __attribute__((address_space(3))) bf16x8*)(kp+2048); kf[3]=*(const __attribute__((address_space(3))) bf16x8*)(kp+2560);
  kf[4]=*(const __attribute__((address_space(3))) bf16x8*)(kp+4096); kf[5]=*(const __attribute__((address_space(3))) bf16x8*)(kp+4608);
  kf[6]=*(const __attribute__((address_space(3))) bf16x8*)(kp+6144); kf[7]=*(const __attribute__((address_space(3))) bf16x8*)(kp+6656);
}
__device__ __forceinline__ void kload2(bf16x8*kf,lds_cptr kp,int j){ kf[2*j]=*(const __attribute__((address_space(3))) bf16x8*)(kp+j*2048); kf[2*j+1]=*(const __attribute__((address_space(3))) bf16x8*)(kp+j*2048+512); }
__device__ __forceinline__ s16x4 vtr(lds_cptr p){ return __builtin_bit_cast(s16x4,__builtin_amdgcn_ds_read_tr16_b64_v4i16((__attribute__((address_space(3))) v4i16_t*)p)); }
__device__ __forceinline__ float rowmax(const f32x16&p0,const f32x16&p1){
  float a=max3f(p0[0],p0[1],p1[0]),b=max3f(p0[2],p0[3],p1[1]);a=max3f(a,p1[2],p1[3]);
  #pragma unroll
  for(int r=4;r<16;r+=4){a=max3f(a,p0[r],p0[r+1]);b=max3f(b,p0[r+2],p0[r+3]);a=max3f(a,p1[r],p1[r+1]);b=max3f(b,p1[r+2],p1[r+3]);}
  const float m=max2f(a,b);
  auto rr=__builtin_amdgcn_permlane32_swap(__float_as_uint(m),__float_as_uint(m),false,false);
  return max2f(__uint_as_float(rr[0]),__uint_as_float(rr[1]));
}
__device__ __forceinline__ void pv(f32x16*o,int vb,bf16x8 pa0,bf16x8 pa1,bf16x8 pa2,bf16x8 pa3){
  #pragma unroll
  for(int d0=0;d0<2;++d0){s16x4 lo[4],hi[4];
    #pragma unroll
    for(int ks=0;ks<4;++ks){
      asm volatile("ds_read_b64_tr_b16 %0,%1 offset:%c2":"=&v"(lo[ks]):"v"(vb),"i"(d0*4096+ks*1024):"memory");
      asm volatile("ds_read_b64_tr_b16 %0,%1 offset:%c2":"=&v"(hi[ks]):"v"(vb),"i"(d0*4096+ks*1024+512):"memory");}
    asm volatile("s_waitcnt lgkmcnt(0)":::"memory");SBAR();
    #define PK(k) (bf16x8){lo[k][0],lo[k][1],lo[k][2],lo[k][3],hi[k][0],hi[k][1],hi[k][2],hi[k][3]}
    o[d0]=__builtin_amdgcn_mfma_f32_32x32x16_bf16(pa0,PK(0),o[d0],0,0,0);
    o[d0]=__builtin_amdgcn_mfma_f32_32x32x16_bf16(pa1,PK(1),o[d0],0,0,0);
    o[d0]=__builtin_amdgcn_mfma_f32_32x32x16_bf16(pa2,PK(2),o[d0],0,0,0);
    o[d0]=__builtin_amdgcn_mfma_f32_32x32x16_bf16(pa3,PK(3),o[d0],0,0,0);
    #undef PK
  }
}

#ifndef ATTN_STORE16
#define ATTN_STORE16(p,v) (*(u32x4*)(p)=(v))
#endif
template<int THRL> __device__ __forceinline__ void attn_unit(int b,int h,int qb,const bf16*Q,const bf16*__restrict__ K,const bf16*__restrict__ V,bf16*O,char*shm){
  const int tid=threadIdx.x,lane=tid&63,r32=lane&31,hi=lane>>5; const int wid=__builtin_amdgcn_readfirstlane(tid>>6);
  const long rowbase=(long)b*SEQ; const int q0=qb*QB; const int kvh=h/(NHEAD/NKVH);
  const bf16*Qw=Q+(rowbase+q0+wid*QBLK)*QP+h*D;
  const bf16*Kh=K+(long)b*SKV*KP+kvh*D,*Vh=V+(long)b*SKV*KP+kvh*D;
  const unsigned lds0=(unsigned)(uintptr_t)shm;
  float*wsf=(float*)(shm+LDS_WS)+wid*64;
  const bf16*ksrc=Kh+(long)lane*KP+wid*8;
  const bf16*vsrc=Vh+(long)(16*(wid&3)+(lane>>2))*KP+(wid>>2)*32+(lane&3)*8;
  const unsigned kdst=lds0+LDS_K+wid*1024, vdst=lds0+LDS_V+wid*1024;
  #define DMA_K(t,slot) glds16(ksrc+(long)(t)*KVBLK*KP,(unsigned)__builtin_amdgcn_readfirstlane(kdst+(slot)))
  #define DMA_V(t,slot) glds16(vsrc+(long)(t)*KVBLK*KP,(unsigned)__builtin_amdgcn_readfirstlane(vdst+(slot)))
  const int vb0=(int)(lds0+LDS_V)+((lane>>4)&1)*32+(lane&3)*8+(4*hi+((lane&15)>>2))*64;
  const char*Kbase=shm+LDS_K; bf16x8 kf[8];
  const lds_cptr shm3=(lds_cptr)shm; const lds_cptr kp0=shm3+LDS_K+hi*1024+r32*16; const lds_cptr vp0=shm3+LDS_V+((lane>>4)&1)*32+(lane&3)*8+(4*hi+((lane&15)>>2))*64;
  DMA_K(0,0);DMA_V(0,0);DMA_K(1,SLOTB);
  bf16x8 qr[4];
  #pragma unroll
  for(int d0=0;d0<4;++d0)qr[d0]=*reinterpret_cast<const bf16x8*>(&Qw[(long)r32*QP+d0*16+hi*8]);
  float mhat=0.f,l_reg=0.f;f32x16 o[2];o[0]=f32x16{};o[1]=f32x16{};f32x16 negm=f32x16{};asm volatile("":"+v"(negm));
  #define CMASK(P0,P1,t) do{}while(0)
  bool resc=false;
  #define START(P0,P1) do{ const float rm=rowmax(P0,P1); resc=false; \
    { const float dl=rm; mhat=fadd_s(mhat,dl); \
      _Pragma("unroll") for(int r=0;r<16;++r){P0[r]=fsub_s(P0[r],dl);P1[r]=fsub_s(P1[r],dl);} \
      _Pragma("unroll") for(int r=0;r<16;++r)negm[r]=-mhat; asm volatile("":"+v"(negm)); } \
    _Pragma("unroll") for(int r=0;r<16;++r)P0[r]=__builtin_amdgcn_exp2f(P0[r]); }while(0)
  #define RESC() do{ if(resc){ asm volatile("s_waitcnt lgkmcnt(0)":::"memory"); \
      _Pragma("unroll") for(int d_=0;d_<2;++d_) _Pragma("unroll") for(int r=0;r<16;++r)o[d_][r]*=wsf[crow(r,hi)]; } }while(0)
  f32x16 pA0,pA1,pB0,pB1;
  int sl_prev=0,sl_cur=0,sl_next=SLOTB;
  #define ROT() do{sl_prev=sl_cur;sl_cur=sl_next;sl_next=(sl_next==(NSLOT-1)*SLOTB)?0:sl_next+SLOTB;}while(0)
  DMA_K(2,2*SLOTB);
  WAIT_BAR(3);
  qkt(pA0,pA1,Kbase,qr,negm,r32,hi);asm volatile("s_nop 15\n\ts_nop 7":"+v"(pA0),"+v"(pA1));CMASK(pA0,pA1,0);
  START(pA0,pA1);
  _Pragma("unroll") for(int r=0;r<16;++r)pA1[r]=__builtin_amdgcn_exp2f(pA1[r]);
  WAIT_BAR(0);
  DMA_K(3,0);DMA_V(1,SLOTB);
  ROT();
  kload8(kf,kp0+sl_cur);
  WAIT_BAR(2);
  s16x4 vlo[8],vhi[8]; u32x4 pw0,pw1,pw2,pw3;
  #define PKW(P,B) cvtpk_s(P[B],P[B+1])
  #define PAF(k) __builtin_bit_cast(bf16x8,pw##k)
  #define VFR(i) (bf16x8){vlo[i][0],vlo[i][1],vlo[i][2],vlo[i][3],vhi[i][0],vhi[i][1],vhi[i][2],vhi[i][3]}
  #define PIN(x) asm volatile("":"+v"(x))
  #define MX3(a,b,c) __builtin_fmaxf(__builtin_fmaxf((a),(b)),(c))
  #define GAPA(MF,A0,A1,A2,A3,W0,W1,PW) do{ MF; sacc+=A0; sacc+=A1; sacc+=A2; sacc+=A3; PIN(sacc); W0; W1; PIN(PW); SBAR(); }while(0)
  #define EX(v) __builtin_amdgcn_exp2f(v)
  #define GAPB(MF,X,B) do{ MF; X[B]=EX(X[B]); X[B+1]=EX(X[B+1]); X[B+2]=EX(X[B+2]); X[B+3]=EX(X[B+3]); PIN(X); SBAR(); }while(0)
  #define VRD(i) do{ vlo[i]=vtr(vp_+(((i)>>2)*4096+((i)&3)*1024)); vhi[i]=vtr(vp_+(((i)>>2)*4096+((i)&3)*1024+512)); }while(0)
  #define KRD(G,j) do{ if(G){ kload2(kf,kp0+sl_next,j); SBAR(); } }while(0)
  #define STEP(C0,C1,P0,P1,t,GK,GV,GL) do{ SBAR(); \
    const lds_cptr vp_=vp0+sl_prev; \
    VRD(0); SBAR(); float sacc=(P0[0]+P0[1]); \
    GAPA(C0=__builtin_amdgcn_mfma_f32_32x32x16_bf16(kf[0],qr[0],negm,0,0,0), P0[2],P0[3],P0[4],P0[5],     pw0[0]=PKW(P0,0), pw0[1]=PKW(P0,2), pw0); \
    VRD(4); SBAR(); GAPA(C1=__builtin_amdgcn_mfma_f32_32x32x16_bf16(kf[1],qr[0],negm,0,0,0), P0[6],P0[7],P0[8],P0[9],     pw0[2]=PKW(P0,4), pw0[3]=PKW(P0,6), pw0); \
    VRD(1); SBAR(); GAPA(C0=__builtin_amdgcn_mfma_f32_32x32x16_bf16(kf[2],qr[1],C0,0,0,0),   P0[10],P0[11],P0[12],P0[13], pw1[0]=PKW(P0,8), pw1[1]=PKW(P0,10), pw1); \
    VRD(5); SBAR(); GAPA(C1=__builtin_amdgcn_mfma_f32_32x32x16_bf16(kf[3],qr[1],C1,0,0,0),   P0[14],P0[15],P1[0],P1[1],   pw1[2]=PKW(P0,12),pw1[3]=PKW(P0,14), pw1); \
    VRD(2); SBAR(); GAPA(C0=__builtin_amdgcn_mfma_f32_32x32x16_bf16(kf[4],qr[2],C0,0,0,0),   P1[2],P1[3],P1[4],P1[5],     pw2[0]=PKW(P1,0), pw2[1]=PKW(P1,2), pw2); \
    VRD(6); SBAR(); GAPA(C1=__builtin_amdgcn_mfma_f32_32x32x16_bf16(kf[5],qr[2],C1,0,0,0),   P1[6],P1[7],P1[8],P1[9],     pw2[2]=PKW(P1,4), pw2[3]=PKW(P1,6), pw2); \
    VRD(3); SBAR(); GAPA(C0=__builtin_amdgcn_mfma_f32_32x32x16_bf16(kf[6],qr[3],C0,0,0,0),   P1[10],P1[11],P1[12],P1[13], pw3[0]=PKW(P1,8), pw3[1]=PKW(P1,10), pw3); \
    VRD(7); SBAR(); GAPA(C1=__builtin_amdgcn_mfma_f32_32x32x16_bf16(kf[7],qr[3],C1,0,0,0),   P1[14],P1[15],0.f,0.f,       pw3[2]=PKW(P1,12),pw3[3]=PKW(P1,14), pw3); \
    l_reg+=sacc; \
    if(GK){DMA_K((t)+3,sl_cur);} if(GV){DMA_V((t)+1,sl_next);} \
    CMASK(C0,C1,t); \
    { float a=MX3(C0[0],C0[1],C1[0]),b=MX3(C0[2],C0[3],C1[1]); a=MX3(a,C1[2],C1[3]); \
      _Pragma("unroll") for(int r=4;r<16;r+=4){a=MX3(a,C0[r],C0[r+1]);b=MX3(b,C0[r+2],C0[r+3]);a=MX3(a,C1[r],C1[r+1]);b=MX3(b,C1[r+2],C1[r+3]);} \
      float rm=__builtin_fmaxf(a,b); { auto rr=__builtin_amdgcn_permlane32_swap(__float_as_uint(rm),__float_as_uint(rm),false,false); rm=__builtin_fmaxf(__uint_as_float(rr[0]),__uint_as_float(rr[1])); } \
      resc=false; \
      if(__builtin_expect(__any(rm>(float)THRL),0)){ const float dl=__builtin_fmaxf(rm,0.f); mhat+=dl; \
        _Pragma("unroll") for(int r=0;r<16;++r){C0[r]-=dl;C1[r]-=dl;} \
        _Pragma("unroll") for(int r=0;r<16;++r)negm[r]=-mhat; asm volatile("":"+v"(negm)); \
        const float f=__builtin_amdgcn_exp2f(-dl); l_reg*=f; if(hi==0)wsf[r32]=f; resc=true; } } \
    SBAR(); \
    GAPB(o[0]=__builtin_amdgcn_mfma_f32_32x32x16_bf16(PAF(0),VFR(0),o[0],0,0,0), C0,0); \
    GAPB(o[1]=__builtin_amdgcn_mfma_f32_32x32x16_bf16(PAF(0),VFR(4),o[1],0,0,0), C0,4); \
    KRD(GL,0); GAPB(o[0]=__builtin_amdgcn_mfma_f32_32x32x16_bf16(PAF(1),VFR(1),o[0],0,0,0), C0,8); \
    KRD(GL,1); GAPB(o[1]=__builtin_amdgcn_mfma_f32_32x32x16_bf16(PAF(1),VFR(5),o[1],0,0,0), C0,12); \
    KRD(GL,2); GAPB(o[0]=__builtin_amdgcn_mfma_f32_32x32x16_bf16(PAF(2),VFR(2),o[0],0,0,0), C1,0); \
    KRD(GL,3); GAPB(o[1]=__builtin_amdgcn_mfma_f32_32x32x16_bf16(PAF(2),VFR(6),o[1],0,0,0), C1,4); \
    GAPB(o[0]=__builtin_amdgcn_mfma_f32_32x32x16_bf16(PAF(3),VFR(3),o[0],0,0,0), C1,8); \
    GAPB(o[1]=__builtin_amdgcn_mfma_f32_32x32x16_bf16(PAF(3),VFR(7),o[1],0,0,0), C1,12); \
    }while(0)
  int t=1;
  #undef CMASK
  #define CMASK(P0,P1,t) do{}while(0)
  for(;t+5<NT;t+=2){
    STEP(pB0,pB1,pA0,pA1,t,true,true,true);     WAIT_BAR(2); RESC(); ROT();
    STEP(pA0,pA1,pB0,pB1,t+1,true,true,true);   WAIT_BAR(2); RESC(); ROT();
  }
  #undef CMASK
  #define CMASK(P0,P1,t) do{}while(0)
  #define ENDW(tt) do{ if((tt)+3<NT){WAIT_BAR(2);} else if((tt)+2<NT){WAIT_BAR(1);} else {WAIT_BAR(0);} }while(0)
  for(;t+1<NT;t+=2){
    STEP(pB0,pB1,pA0,pA1,t,(t+3<NT),(t+1<NT),(t+1<NT));       ENDW(t);   RESC(); ROT();
    STEP(pA0,pA1,pB0,pB1,t+1,(t+4<NT),(t+2<NT),(t+2<NT));     ENDW(t+1); RESC(); ROT();
  }
  STEP(pB0,pB1,pA0,pA1,NT-1,false,false,false); RESC();
  { float sacc=pB0[0]+pB0[1]; _Pragma("unroll") for(int r=2;r<16;++r)sacc+=pB0[r]; _Pragma("unroll") for(int r=0;r<16;++r)sacc+=pB1[r]; l_reg+=sacc;
    pw0=(u32x4){PKW(pB0,0),PKW(pB0,2),PKW(pB0,4),PKW(pB0,6)};pw1=(u32x4){PKW(pB0,8),PKW(pB0,10),PKW(pB0,12),PKW(pB0,14)};pw2=(u32x4){PKW(pB1,0),PKW(pB1,2),PKW(pB1,4),PKW(pB1,6)};pw3=(u32x4){PKW(pB1,8),PKW(pB1,10),PKW(pB1,12),PKW(pB1,14)};
    SBAR(); pv(o,vb0+sl_cur,PAF(0),PAF(1),PAF(2),PAF(3)); }
  #undef PKW
  #undef PAF
  #undef VFR
  #undef PIN
  #undef MX3
  #undef GAPA
  #undef GAPB
  #undef EX
  #undef VRD
  #undef KRD
  #undef STEP
  #undef ENDW
  {auto rr=__builtin_amdgcn_permlane32_swap(__float_as_uint(l_reg),__float_as_uint(l_reg),false,false);l_reg=__uint_as_float(rr[0])+__uint_as_float(rr[1]);}
  if(hi==0)wsf[32+r32]=l_reg;asm volatile("s_waitcnt lgkmcnt(0)":::"memory");
  float rli[16];
  #pragma unroll
  for(int r=0;r<16;++r)rli[r]=__builtin_amdgcn_rcpf(wsf[32+crow(r,hi)]);
  bf16*Ow=O+(rowbase+q0+wid*QBLK)*OP+h*D;
  { bf16*stg=(bf16*)(shm+LDS_OST)+wid*2048;
    #pragma unroll
    for(int r=0;r<16;++r){const int orow=crow(r,hi);
      #pragma unroll
      for(int d0=0;d0<2;++d0)stg[orow*64+d0*32+r32]=__float2bfloat16(o[d0][r]*rli[r]);}
    asm volatile("s_waitcnt lgkmcnt(0)":::"memory");
    #pragma unroll
    for(int i=0;i<4;++i){const int row=i*8+(lane>>3),ch=lane&7; const u32x4 v=*(const u32x4*)(stg+row*64+ch*8); ATTN_STORE16(Ow+(long)row*OP+ch*8,v);} }
  asm volatile("s_waitcnt lgkmcnt(0)\n\ts_barrier":::"memory");
  #undef DMA_K
  #undef DMA_V
  #undef CMASK
  #undef START
  #undef RESC
  #undef ROT
}
constexpr int ATTN_LDS_BYTES=LDS_BYTES;
struct AttnTensors { const bf16* Q; const bf16* K; const bf16* V; bf16* O; };
struct AttnUnit { int b; int h; int qb; };
struct StaticOrder {
  int vcu, G;
  __device__ __forceinline__ StaticOrder(int grid,int block):vcu((grid%8==0)?(block%8)*(grid/8)+block/8:block),G(grid){}
  __device__ __forceinline__ bool next(int i,AttnUnit&u)const{ const int j=vcu+i*G; if(j>=4*NHEAD*NQB)return false; const int r=j/NQB; u.qb=j%NQB; const int bk=r%8, hl=r/8; u.b=bk/NKVH; u.h=(bk%NKVH)*(NHEAD/NKVH)+hl; return true; }
};
template<int THRL=8> __device__ __forceinline__ void attn_phase(char*lds,const AttnTensors&T,const StaticOrder&S){
  AttnUnit u;
  for(int i=0;S.next(i,u);++i){ attn_unit<THRL>(u.b,u.h,u.qb,T.Q,T.K,T.V,T.O,lds); }
}
#undef SBAR
#undef WAIT_BAR
}
#define GAS __attribute__((address_space(1)))
#define LAS __attribute__((address_space(3)))
typedef unsigned short bf16;
typedef unsigned v4u __attribute__((ext_vector_type(4)));
typedef float f32x4 __attribute__((ext_vector_type(4)));
typedef short bf16x8 __attribute__((ext_vector_type(8)));
typedef GAS unsigned gu32;
typedef GAS unsigned long long gu64;
#define RLX_AGENT __ATOMIC_RELAXED, __HIP_MEMORY_SCOPE_AGENT
#define LDS_WAIT() asm volatile("s_waitcnt lgkmcnt(0)" ::: "memory")
#define VM_WAIT() asm volatile("s_waitcnt vmcnt(0)" ::: "memory")
__device__ __forceinline__ unsigned long long rt() { return __builtin_amdgcn_s_memrealtime(); }
__device__ __forceinline__ unsigned f2bf(float f) { unsigned u = __builtin_bit_cast(unsigned, f); return (u + 0x7fffu + ((u >> 16) & 1u)) >> 16; }
__device__ __forceinline__ unsigned pk2(float lo, float hi) { return f2bf(lo) | (f2bf(hi) << 16); }

#define XB_TMO      128
#define XB_XCNT(j)  (256  + 64 * (j))
#define XB_XSUB(j)  (1280 + 64 * (j))
#define XB_XGEN(j)  (2304 + 64 * (j))
#define XB_TOP      3328
#define XB_TOPGEN   3392
#define XCD_BAR_WORDS 3456
#define XB_SPIN_CAP (1u << 18)

__device__ __forceinline__ unsigned xb_ld(unsigned* p)              { return __hip_atomic_load(p, __ATOMIC_RELAXED, __HIP_MEMORY_SCOPE_AGENT); }
__device__ __forceinline__ unsigned xb_add(unsigned* p, unsigned v) { return __hip_atomic_fetch_add(p, v, __ATOMIC_RELAXED, __HIP_MEMORY_SCOPE_AGENT); }
__device__ __forceinline__ unsigned xb_xcc_id() { return (unsigned)__builtin_amdgcn_s_getreg((3 << 11) | 20) & 0xFu; }
#define XB_SPIN(cond, bar) do { unsigned _sp = 0; while (cond) { __builtin_amdgcn_s_sleep(1); \
    if ((++_sp & 255u) == 0u) { if (xb_ld(&(bar)[XB_TMO])) break; if (_sp > XB_SPIN_CAP) { atomicAdd(&(bar)[XB_TMO], 1u); break; } } } } while (0)

struct XcdBarrier {
    unsigned* bar; unsigned x;
    volatile LAS unsigned* st;
};

__device__ __forceinline__ XcdBarrier xcd_barrier_post(unsigned* bar, volatile LAS unsigned* st) {
    XcdBarrier b; b.bar = bar; b.x = xb_xcc_id(); b.st = st;
    if (threadIdx.x == 0) (void)xb_add(&bar[XB_XCNT(b.x)], 1u);
    return b;
}
__device__ __forceinline__ void xcd_barrier_complete(unsigned* bar, unsigned x, unsigned& nloc, unsigned& nx) {
    const unsigned G = gridDim.x * gridDim.y * gridDim.z;
    unsigned sum, cnt, mine, sp = 0u;
    for (;;) {
        sum = 0u; cnt = 0u; mine = 0u;
#pragma unroll
        for (unsigned j = 0; j < 16; ++j) { const unsigned c = xb_ld(&bar[XB_XCNT(j)]); sum += c; cnt += (c > 0u) ? 1u : 0u; mine = (j == x) ? c : mine; }
        if (sum == G) break;
        __builtin_amdgcn_s_sleep(1);
        if ((++sp & 255u) == 0u) { if (xb_ld(&bar[XB_TMO])) break; if (sp > XB_SPIN_CAP) { atomicAdd(&bar[XB_TMO], 1u); break; } }
    }
    nloc = mine > 0u ? mine : 1u; nx = cnt > 0u ? cnt : 1u;
}

__device__ __forceinline__ void xcd_barrier(const XcdBarrier& b) {
    asm volatile("s_waitcnt vmcnt(0)" ::: "memory");
    __syncthreads();
    if (threadIdx.x == 0) {
        unsigned* bar = b.bar;
        __builtin_amdgcn_s_waitcnt(0);
        unsigned nloc = b.st[0], nx = b.st[1];
        if (nloc == 0u) { xcd_barrier_complete(bar, b.x, nloc, nx); b.st[0] = nloc; b.st[1] = nx; }
        const unsigned old = xb_add(&bar[XB_XSUB(b.x)], 1u);
        const unsigned gen = old / nloc;
        if (old + 1u == (gen + 1u) * nloc) {
            __builtin_amdgcn_fence(__ATOMIC_RELEASE, "agent");
            asm volatile("s_waitcnt vmcnt(0)" ::: "memory");
            const unsigned og = xb_add(&bar[XB_TOP], 1u);
            const unsigned tg = og / nx;
            if (og + 1u == (tg + 1u) * nx) xb_add(&bar[XB_TOPGEN], 1u);
            else XB_SPIN(xb_ld(&bar[XB_TOPGEN]) == tg, bar);
            __builtin_amdgcn_fence(__ATOMIC_ACQUIRE, "agent");
            xb_add(&bar[XB_XGEN(b.x)], 1u);
            asm volatile("s_waitcnt vmcnt(0)" ::: "memory");
        } else {
            XB_SPIN(xb_ld(&bar[XB_XGEN(b.x)]) == gen, bar);
            __builtin_amdgcn_fence(__ATOMIC_ACQUIRE, "agent");
            asm volatile("s_waitcnt vmcnt(0)" ::: "memory");
        }
    }
    __syncthreads();
}

constexpr int NWAVES = 8;
constexpr int DM = 1024, NBATCH = 4, SEQ = 8192, M = NBATCH * SEQ, CTXL = 256, MC = NBATCH * CTXL, MA = M + MC;
constexpr int NIN = 2304, SKV = SEQ + CTXL;
constexpr int DFF = 2816, NEXP = 8, EFF = 3584, NCHUNK = M / 128;
constexpr float EPS = 1e-6f;
constexpr int N_PHASES = 16;
#ifndef MK_PER_PHASE
#define MK_PER_PHASE 0
#endif

constexpr size_t MiB = 1u << 20, QM = 256u * 1024u;
constexpr size_t WS_CTL = 0, CTL_ZERO_BYTES = 1 * MiB;
constexpr size_t WS_MODV = 1 * MiB;
constexpr size_t WS_ROPE = 1 * MiB + QM;
constexpr size_t WS_PERM = 2 * MiB;
constexpr size_t WS_TOKSLOT = 3 * MiB, WS_TOKW = 3 * MiB + QM;
constexpr size_t WS_WIN = 16 * QM, WS_WOUT = 34 * QM, WS_WGU = 42 * QM, WS_WD = 86 * QM, WS_WGIN = 108 * QM, WS_WGOUT = 124 * QM, WS_WSB = 132 * QM, WS_WEGU = 136 * QM, WS_WED = 584 * QM;
constexpr size_t A0 = 808 * QM;
constexpr size_t WS_HX = A0, WS_QKV = A0 + 66 * MiB, WS_Q = A0 + 858 * QM  , WS_KALL = A0 + 986 * QM  , WS_VALL = A0 + 1019 * QM  , WS_AC = A0 + 263 * MiB;
constexpr size_t WS_Y = A0, WS_H2 = A0 + 66 * MiB, WS_HID = A0 + 130 * MiB;
constexpr size_t WS_U = A0 + 130 * MiB, WS_VT = A0 + 194 * MiB, WS_GM = A0 + 258 * MiB, WS_H4 = A0 + 308 * MiB, WS_HIDE = A0, WS_OSL = A0 + 112 * MiB;
constexpr size_t WS_END = A0 + 372 * MiB;
static_assert(WS_WIN + (size_t)NIN * DM * 2 <= WS_WOUT && WS_WOUT + (size_t)DM * DM * 2 <= WS_WGU && WS_WGU + (size_t)2 * DFF * DM * 2 <= WS_WD && WS_WD + (size_t)DM * DFF * 2 <= WS_WGIN &&
              WS_WGIN + (size_t)2048 * DM * 2 <= WS_WGOUT && WS_WGOUT + (size_t)DM * DM * 2 <= WS_WSB && WS_WSB + (size_t)8 * 128 * 128 * 2 <= WS_WEGU && WS_WEGU + (size_t)NEXP * 2 * EFF * DM * 2 <= WS_WED &&
              WS_WED + (size_t)NEXP * DM * EFF * 2 <= A0, "weight map");
static_assert(WS_HX + (size_t)MA * DM * 2 <= WS_QKV && WS_QKV + (size_t)MA * NIN * 2 <= WS_Q && WS_Q + (size_t)M * 512 * 2 <= WS_KALL && WS_KALL + (size_t)NBATCH * SKV * 128 * 2 <= WS_VALL &&
              WS_VALL + (size_t)NBATCH * SKV * 128 * 2 <= WS_AC && WS_AC + (size_t)M * DM * 2 <= WS_END, "layer-0 activation map");
static_assert(WS_HID + (size_t)M * DFF * 2 <= WS_END && WS_H2 + (size_t)M * DM * 2 <= WS_HID && WS_GM + (size_t)M * DM * 2 <= WS_END && WS_HIDE + (size_t)64 * 256 * EFF * 2 <= WS_OSL &&
              WS_OSL + (size_t)264 * 256 * DM * 2 <= WS_H4 && WS_H4 + (size_t)M * DM * 2 <= WS_END, "layer-1 activation map");
constexpr int CW_TMO = 0, CW_CODE = 1, CW_BAR = 4096, CW_CNT = 8192;

constexpr int RING_OFF = 0, RING_BYTES = 131072;
constexpr int LDSCTL_OFF = RING_BYTES, MISC_OFF = LDSCTL_OFF + 320;
constexpr int MOE_OFF = LDSCTL_OFF + 512;
constexpr int IDX_OFF = LDSCTL_OFF + 2048;
constexpr int LDS_BYTES = 147456;
static_assert(MOE_OFF + (32 + 272) * 4 <= IDX_OFF && IDX_OFF + 8 * 256 * 4 <= LDS_BYTES, "LDS map");

struct Frame {
    LAS unsigned char* lds;
    volatile LAS unsigned* MISC;
    gu32* ctl;
    int tid, lane, wave;
    int vcu, G;
};
struct Args { const float* in[35]; float* out; unsigned char* ws; int ph_lo, ph_hi; };

__device__ __forceinline__ float wave_sum(float v) {
#pragma unroll
    for (int o = 1; o < 64; o <<= 1) v += __shfl_xor(v, o);
    return v;
}
__device__ __forceinline__ float bf_lo(unsigned u) { return __uint_as_float(u << 16); }
__device__ __forceinline__ float bf_hi(unsigned u) { return __uint_as_float(u & 0xffff0000u); }
__device__ __forceinline__ float sq4(const f32x4 v) { return (v.x * v.x + v.y * v.y) + (v.z * v.z + v.w * v.w); }
typedef unsigned u32x2 __attribute__((ext_vector_type(2)));
__device__ __forceinline__ void ld_row_f32(const float* row, int lane, f32x4 (&v)[4]) { const GAS f32x4* p = (const GAS f32x4*)row + lane;
#pragma unroll
    for (int j = 0; j < 4; ++j) v[j] = p[64 * j]; }
__device__ __forceinline__ void st_row_f32(float* row, int lane, const f32x4 (&v)[4]) { GAS f32x4* p = (GAS f32x4*)row + lane;
#pragma unroll
    for (int j = 0; j < 4; ++j) p[64 * j] = v[j]; }
__device__ __forceinline__ void ld_row_bf16(const bf16* row, int lane, f32x4 (&v)[4]) { const GAS u32x2* p = (const GAS u32x2*)row + lane;
#pragma unroll
    for (int j = 0; j < 4; ++j) { const u32x2 w = p[64 * j]; v[j] = (f32x4){bf_lo(w.x), bf_hi(w.x), bf_lo(w.y), bf_hi(w.y)}; } }
__device__ __forceinline__ void st_row_bf16(bf16* row, int lane, const f32x4 (&v)[4]) { GAS u32x2* p = (GAS u32x2*)row + lane;
#pragma unroll
    for (int j = 0; j < 4; ++j) { u32x2 w; w.x = pk2(v[j].x, v[j].y); w.y = pk2(v[j].z, v[j].w); p[64 * j] = w; } }
__device__ __forceinline__ void unpack8(const v4u w, float (&f)[8]) { f[0] = bf_lo(w.x); f[1] = bf_hi(w.x); f[2] = bf_lo(w.y); f[3] = bf_hi(w.y); f[4] = bf_lo(w.z); f[5] = bf_hi(w.z); f[6] = bf_lo(w.w); f[7] = bf_hi(w.w); }
__device__ __forceinline__ v4u pack8(const float (&f)[8]) { v4u w; w.x = pk2(f[0], f[1]); w.y = pk2(f[2], f[3]); w.z = pk2(f[4], f[5]); w.w = pk2(f[6], f[7]); return w; }
__device__ __forceinline__ const float* modp(const float* modv, int layer, int j, int chunk) { return modv + ((size_t)(layer * 5 + j) * 6 + chunk) * DM; }

__device__ __forceinline__ void tr_item(const float* W, int K, int N, bf16* WT, int kb, int nb, int drow0, LAS float* scr, int lane) {
    const int k0 = 64 * kb, n0 = 32 * nb;
#pragma unroll 8
    for (int i = 0; i < 32; ++i) { const int kk = 2 * i + (lane >> 5); scr[kk * 33 + (lane & 31)] = W[(size_t)(k0 + kk) * N + n0 + (lane & 31)]; }
    LDS_WAIT(); asm volatile("" ::: "memory");
    const int c = lane & 7;
#pragma unroll
    for (int j = 0; j < 4; ++j) { const int n = (lane >> 3) + 8 * j; const LAS float* s = scr + (8 * c) * 33 + n;
        v4u o; o.x = pk2(s[0 * 33], s[1 * 33]); o.y = pk2(s[2 * 33], s[3 * 33]); o.z = pk2(s[4 * 33], s[5 * 33]); o.w = pk2(s[6 * 33], s[7 * 33]);
        *(GAS v4u*)(WT + (size_t)(drow0 + n) * K + k0 + 8 * c) = o; }
    LDS_WAIT(); asm volatile("" ::: "memory");
}
__device__ __forceinline__ int swiglu_row(int n0) { return 256 * (n0 >> 7) + (n0 & 127); }
__device__ __forceinline__ void sincos_small(float a, float& s, float& c) {
    const float kf = rintf(a * 0.636619772f); const int k = (int)kf;
    float r = fmaf(-kf, 1.5707962513e+00f, a); r = fmaf(-kf, 7.5497894159e-08f, r); r = fmaf(-kf, 5.3903029534e-15f, r);
    const float r2 = r * r;
    const float sp = r + r * r2 * (-1.6666654611e-1f + r2 * (8.3321608736e-3f + r2 * (-1.9515295891e-4f)));
    const float cp = 1.0f - 0.5f * r2 + r2 * r2 * (4.166664568298827e-2f + r2 * (-1.388731625493765e-3f + r2 * 2.443315711809948e-5f));
    const int q = k & 3;
    s = (q == 0) ? sp : (q == 1) ? cp : (q == 2) ? -sp : -cp;
    c = (q == 0) ? cp : (q == 1) ? -sp : (q == 2) ? -cp : sp;
}
__device__ __forceinline__ void p0_mod_item(Frame& F, const float* W, const float* bias, const float* c, const float* cctx, float* modv_layer, int cb) {
    const int col0 = cb * 256; LAS float* red = (LAS float*)F.lds;
    f32x4 acc[5];
#pragma unroll
    for (int j = 0; j < 5; ++j) acc[j] = (f32x4){0.f, 0.f, 0.f, 0.f};
    const int k0 = F.wave * 128;
#pragma unroll 4
    for (int k = k0; k < k0 + 128; ++k) {
        const f32x4 wv = *(const GAS f32x4*)(W + (size_t)k * 6144 + col0 + 4 * F.lane);
#pragma unroll
        for (int j = 0; j < 5; ++j) { const float cj = (j < 4) ? c[j * DM + k] : cctx[k]; const float s = cj / (1.0f + __expf(-cj)); acc[j] += wv * s; }
    }
#pragma unroll
    for (int j = 0; j < 5; ++j) *(LAS f32x4*)(red + ((F.wave * 5 + j) * 256 + 4 * F.lane)) = acc[j];
    __syncthreads();
    for (int o = F.tid; o < 5 * 256; o += NWAVES * 64) { const int j = o >> 8, cc = o & 255; float s = bias[col0 + cc];
#pragma unroll
        for (int w = 0; w < 8; ++w) s += red[(w * 5 + j) * 256 + cc];
        modv_layer[(size_t)j * 6144 + col0 + cc] = s; }
    __syncthreads();
}
__device__ __forceinline__ void p0_prologue(Frame& F, const Args& a) {
    unsigned char* ws = a.ws;
    float* modv = (float*)(ws + WS_MODV);
    for (int it = blockIdx.x; it < 48; it += F.G) { const int layer = it / 24, cb = it % 24;
        p0_mod_item(F, layer ? a.in[18] : a.in[4], layer ? a.in[19] : a.in[5], a.in[1], a.in[3], modv + (size_t)layer * 5 * 6144, cb); }
    const int gt = blockIdx.x * (NWAVES * 64) + F.tid, NGT = F.G * NWAVES * 64;
    { float* tab = (float*)(ws + WS_ROPE);
      for (int i = gt; i < 192 * 16; i += NGT) { const int p = i >> 4, k = i & 15; const float pos = (float)(p < 128 ? p : p - 128);
          const float inv = 1.0f / powf(10000.0f, (float)(2 * k) / 32.0f); float s, c; sincos_small(pos * inv, s, c); tab[2 * i] = c; tab[2 * i + 1] = s; } }
    { const float* wsf = a.in[25]; bf16* wsb = (bf16*)(ws + WS_WSB);
      for (int i = gt; i < 8 * 128 * 128 / 4; i += NGT) { const f32x4 v = *(const GAS f32x4*)(wsf + 4 * (size_t)i); u32x2 w; w.x = pk2(v.x, v.y); w.y = pk2(v.z, v.w); *(GAS u32x2*)(wsb + 4 * (size_t)i) = w; } }
    LAS float* scr = (LAS float*)(F.lds + RING_OFF + F.wave * 16384);
    const int gw = F.vcu * NWAVES + F.wave, NGW = F.G * NWAVES;
    constexpr int I_WIN = 16 * 72, I_WOUT = 16 * 32, I_FG = 16 * 88, I_FD = 44 * 32, I_GIN = 16 * 64, I_GOUT = 16 * 32, I_EG = 16 * 112, I_ED = 56 * 32;
    constexpr int NITEMS = I_WIN + I_WOUT + 2 * I_FG + I_FD + I_GIN + I_GOUT + NEXP * (2 * I_EG + I_ED);
    for (int it = gw; it < NITEMS; it += NGW) {
        int r = it;
        if (r < I_WIN) { tr_item(a.in[8], DM, NIN, (bf16*)(ws + WS_WIN), r / 72, r % 72, 32 * (r % 72), scr, F.lane); continue; } r -= I_WIN;
        if (r < I_WOUT) { tr_item(a.in[12], DM, DM, (bf16*)(ws + WS_WOUT), r / 32, r % 32, 32 * (r % 32), scr, F.lane); continue; } r -= I_WOUT;
        if (r < I_FG) { tr_item(a.in[15], DM, DFF, (bf16*)(ws + WS_WGU), r / 88, r % 88, swiglu_row(32 * (r % 88)), scr, F.lane); continue; } r -= I_FG;
        if (r < I_FG) { tr_item(a.in[16], DM, DFF, (bf16*)(ws + WS_WGU), r / 88, r % 88, swiglu_row(32 * (r % 88)) + 128, scr, F.lane); continue; } r -= I_FG;
        if (r < I_FD) { tr_item(a.in[17], DFF, DM, (bf16*)(ws + WS_WD), r / 32, r % 32, 32 * (r % 32), scr, F.lane); continue; } r -= I_FD;
        if (r < I_GIN) { tr_item(a.in[22], DM, 2048, (bf16*)(ws + WS_WGIN), r / 64, r % 64, 32 * (r % 64), scr, F.lane); continue; } r -= I_GIN;
        if (r < I_GOUT) { tr_item(a.in[27], DM, DM, (bf16*)(ws + WS_WGOUT), r / 32, r % 32, 32 * (r % 32), scr, F.lane); continue; } r -= I_GOUT;
        if (r < NEXP * I_EG) { const int e = r / I_EG, q = r % I_EG; tr_item(a.in[32] + (size_t)e * DM * EFF, DM, EFF, (bf16*)(ws + WS_WEGU), q / 112, q % 112, e * 2 * EFF + swiglu_row(32 * (q % 112)), scr, F.lane); continue; } r -= NEXP * I_EG;
        if (r < NEXP * I_EG) { const int e = r / I_EG, q = r % I_EG; tr_item(a.in[33] + (size_t)e * DM * EFF, DM, EFF, (bf16*)(ws + WS_WEGU), q / 112, q % 112, e * 2 * EFF + swiglu_row(32 * (q % 112)) + 128, scr, F.lane); continue; } r -= NEXP * I_EG;
        { const int e = r / I_ED, q = r % I_ED; tr_item(a.in[34] + (size_t)e * EFF * DM, EFF, DM, (bf16*)(ws + WS_WED), q / 32, q % 32, e * DM + 32 * (q % 32), scr, F.lane); }
    }
}

__device__ __forceinline__ void prenorm_rows16(const float* src, bf16* dst, int lane, const f32x4 (&aa)[4], const f32x4 (&sh)[4], int nrows) {
    for (int i = 0; i < nrows; ++i) {
        f32x4 v[4]; ld_row_f32(src + (size_t)i * DM, lane, v);
        const float ss = wave_sum((sq4(v[0]) + sq4(v[1])) + (sq4(v[2]) + sq4(v[3])));
        const float rstd = rsqrtf(ss * (1.0f / DM) + EPS);
#pragma unroll
        for (int j = 0; j < 4; ++j) v[j] = v[j] * rstd * aa[j] + sh[j];
        st_row_bf16(dst + (size_t)i * DM, lane, v);
    }
}
__device__ __forceinline__ void load_pre_vecs(const float* modv, int layer, int j, int ch_shift, int ch_scale, const float* g, int lane, f32x4 (&aa)[4], f32x4 (&sh)[4]) {
    f32x4 sc[4], gg[4]; ld_row_f32(modp(modv, layer, j, ch_scale), lane, sc); ld_row_f32(g, lane, gg); ld_row_f32(modp(modv, layer, j, ch_shift), lane, sh);
#pragma unroll
    for (int k = 0; k < 4; ++k) aa[k] = gg[k] * (sc[k] + 1.0f);
}
__device__ __forceinline__ void p1_prenorm(Frame& F, const Args& a) {
    const float* modv = (const float*)(a.ws + WS_MODV); bf16* HX = (bf16*)(a.ws + WS_HX);
    const int gw = F.vcu * NWAVES + F.wave, NGW = F.G * NWAVES;
    for (int blk = gw; blk < M / 16; blk += NGW) { const int m0 = blk * 16, b = m0 / SEQ;
        f32x4 aa[4], sh[4]; load_pre_vecs(modv, 0, b, 0, 1, a.in[6], F.lane, aa, sh);
        prenorm_rows16(a.in[0] + (size_t)m0 * DM, HX + (size_t)m0 * DM, F.lane, aa, sh, 16); }
    for (int blk = gw; blk < MC / 16; blk += NGW) { const int m0 = blk * 16;
        f32x4 aa[4], sh[4]; load_pre_vecs(modv, 0, 4, 0, 1, a.in[6], F.lane, aa, sh);
        prenorm_rows16(a.in[2] + (size_t)m0 * DM, HX + (size_t)(M + m0) * DM, F.lane, aa, sh, 16); }
}

constexpr float ATT_C2 = 0.125f * 1.4426950408889634f;
__device__ __forceinline__ void norm_rope8(float (&x)[8], const float (&g)[8], int lane, bool do_rope, const float* tab_lo  , float outscale) {
    float ss = 0.f;
#pragma unroll
    for (int e = 0; e < 8; ++e) ss += x[e] * x[e];
    ss += __shfl_xor(ss, 1); ss += __shfl_xor(ss, 2); ss += __shfl_xor(ss, 4);
    const float rstd = rsqrtf(ss * (1.0f / 64.0f) + EPS);
#pragma unroll
    for (int e = 0; e < 8; ++e) x[e] = x[e] * rstd * g[e];
    float p[8];
#pragma unroll
    for (int e = 0; e < 8; ++e) p[e] = __shfl_xor(x[e], 4);
    if (do_rope) {
        const bool upper = (lane & 4) != 0;
#pragma unroll
        for (int e = 0; e < 8; ++e) { const float cs = tab_lo[2 * e], sn = tab_lo[2 * e + 1]; x[e] = upper ? (x[e] * cs + p[e] * sn) : (x[e] * cs - p[e] * sn); }
    }
#pragma unroll
    for (int e = 0; e < 8; ++e) x[e] *= outscale;
}
__device__ __forceinline__ void p3_qkv_post(Frame& F, const Args& a) {
    unsigned char* ws = a.ws;
    const bf16* QKV = (const bf16*)(ws + WS_QKV); bf16* Q = (bf16*)(ws + WS_Q); bf16* KALL = (bf16*)(ws + WS_KALL); bf16* VALL = (bf16*)(ws + WS_VALL); bf16* AC = (bf16*)(ws + WS_AC);
    const float* tab = (const float*)(ws + WS_ROPE); const float* gq = a.in[9]; const float* gk = a.in[10]; const float* wconv = a.in[11];
    const int lane = F.lane, gw = F.vcu * NWAVES + F.wave, NGW = F.G * NWAVES;
    const int d0 = 8 * (lane & 7);
    float gq8[8], gk8[8], w0[8], w1[8], w2[8];
#pragma unroll
    for (int e = 0; e < 8; ++e) { gq8[e] = gq[d0 + e]; gk8[e] = gk[d0 + e]; w0[e] = wconv[8 * lane + e]; w1[e] = wconv[512 + 8 * lane + e]; w2[e] = wconv[1024 + 8 * lane + e]; }
    const int pi0 = 8 * (lane & 3);
    for (int m = gw; m < MA; m += NGW) {
        const bf16* row = QKV + (size_t)m * NIN;
        if (m < M) {
            const int b = m / SEQ, t = m % SEQ, gr = t >> 6, gc = t & 63;
            const float* tl = tab + 2 * (size_t)((pi0 < 16 ? gr : 128 + gc) * 16 + (pi0 & 15));
            { float x[8]; unpack8(*(const GAS v4u*)(row + 8 * lane), x); norm_rope8(x, gq8, lane, true, tl, ATT_C2); *(GAS v4u*)(Q + (size_t)m * 512 + 8 * lane) = pack8(x); }
            { float x[8]; v4u kw = (v4u){0u, 0u, 0u, 0u}; if (lane < 16) kw = *(const GAS v4u*)(row + 512 + 8 * lane); unpack8(kw, x); norm_rope8(x, gk8, lane, true, tl, 1.0f);
              const size_t kvrow = (size_t)b * SKV + CTXL + t;
              if (lane < 16) { *(GAS v4u*)(KALL + kvrow * 128 + 8 * lane) = pack8(x); *(GAS v4u*)(VALL + kvrow * 128 + 8 * lane) = *(const GAS v4u*)(row + 640 + 8 * lane); } }
            { float Bg[8], c0[8], h0[8], z[8], zp[8], zn[8];
              unpack8(*(const GAS v4u*)(row + 768 + 8 * lane), Bg); unpack8(*(const GAS v4u*)(row + 1280 + 8 * lane), c0); unpack8(*(const GAS v4u*)(row + 1792 + 8 * lane), h0);
#pragma unroll
              for (int e = 0; e < 8; ++e) { z[e] = c0[e] * h0[e]; zp[e] = 0.f; zn[e] = 0.f; }
              if (t > 0) { float c1[8], h1[8]; unpack8(*(const GAS v4u*)(row - NIN + 1280 + 8 * lane), c1); unpack8(*(const GAS v4u*)(row - NIN + 1792 + 8 * lane), h1);
#pragma unroll
                  for (int e = 0; e < 8; ++e) zp[e] = c1[e] * h1[e]; }
              if (t < SEQ - 1) { float c1[8], h1[8]; unpack8(*(const GAS v4u*)(row + NIN + 1280 + 8 * lane), c1); unpack8(*(const GAS v4u*)(row + NIN + 1792 + 8 * lane), h1);
#pragma unroll
                  for (int e = 0; e < 8; ++e) zn[e] = c1[e] * h1[e]; }
              float o[8];
#pragma unroll
              for (int e = 0; e < 8; ++e) o[e] = Bg[e] * (w0[e] * zp[e] + w1[e] * z[e] + w2[e] * zn[e]);
              *(GAS v4u*)(AC + (size_t)m * DM + 512 + 8 * lane) = pack8(o); }
        } else {
            const int j = m - M, b = j / CTXL, jj = j % CTXL;
            float x[8]; v4u kw = (v4u){0u, 0u, 0u, 0u}; if (lane < 16) kw = *(const GAS v4u*)(row + 512 + 8 * lane); unpack8(kw, x); norm_rope8(x, gk8, lane, false, tab, 1.0f);
            const size_t kvrow = (size_t)b * SKV + jj;
            if (lane < 16) { *(GAS v4u*)(KALL + kvrow * 128 + 8 * lane) = pack8(x); *(GAS v4u*)(VALL + kvrow * 128 + 8 * lane) = *(const GAS v4u*)(row + 640 + 8 * lane); }
        }
    }
}

template <bool ROUTE>
__device__ __forceinline__ void rows_update(Frame& F, const Args& a, const float* xin, const bf16* Y, int layer, int ch_gate, const float* gpost, int nlayer, int ch_shift, int ch_scale, const float* gpre, bf16* H) {
    const float* modv = (const float*)(a.ws + WS_MODV); float* xout = a.out;
    const int lane = F.lane, gw = F.vcu * NWAVES + F.wave, NGW = F.G * NWAVES;
    LAS float* wrl = (LAS float*)(F.lds + RING_OFF);
    if (ROUTE) { const float* wr = a.in[30]; for (int i = F.tid; i < DM * NEXP / 4; i += NWAVES * 64) *(LAS f32x4*)(wrl + 4 * i) = *(const GAS f32x4*)(wr + 4 * i); __syncthreads(); }
    for (int blk = gw; blk < M / 16; blk += NGW) { const int m0 = blk * 16, b = m0 / SEQ;
        f32x4 gg[4], aa[4], sh[4];
        { f32x4 gt[4], gp[4]; ld_row_f32(modp(modv, layer, b, ch_gate), lane, gt); ld_row_f32(gpost, lane, gp);
#pragma unroll
          for (int k = 0; k < 4; ++k) gg[k] = gt[k] * gp[k]; }
        load_pre_vecs(modv, nlayer, b, ch_shift, ch_scale, gpre, lane, aa, sh);
        int me0 = 0, me1 = 0; float mw0 = 0.f, mw1 = 0.f;
        for (int i = 0; i < 16; ++i) { const size_t m = (size_t)(m0 + i);
            f32x4 x[4], y[4]; ld_row_f32(xin + m * DM, lane, x); ld_row_bf16(Y + m * DM, lane, y);
            const float ssy = wave_sum((sq4(y[0]) + sq4(y[1])) + (sq4(y[2]) + sq4(y[3])));
            const float ry = rsqrtf(ssy * (1.0f / DM) + EPS);
#pragma unroll
            for (int j = 0; j < 4; ++j) x[j] = x[j] + gg[j] * (y[j] * ry);
            st_row_f32(xout + m * DM, lane, x);
            const float ssx = wave_sum((sq4(x[0]) + sq4(x[1])) + (sq4(x[2]) + sq4(x[3])));
            const float rx = rsqrtf(ssx * (1.0f / DM) + EPS);
#pragma unroll
            for (int j = 0; j < 4; ++j) x[j] = x[j] * rx * aa[j] + sh[j];
            st_row_bf16(H + m * DM, lane, x);
            if (ROUTE) {
                float lg[8];
#pragma unroll
                for (int e = 0; e < 8; ++e) lg[e] = 0.f;
#pragma unroll
                for (int j = 0; j < 4; ++j)
#pragma unroll
                    for (int q = 0; q < 4; ++q) { const LAS float* wp = wrl + (256 * j + 4 * lane + q) * 8; const f32x4 wa = *(const LAS f32x4*)wp, wb = *(const LAS f32x4*)(wp + 4); const float hv = x[j][q];
                        lg[0] += hv * wa.x; lg[1] += hv * wa.y; lg[2] += hv * wa.z; lg[3] += hv * wa.w; lg[4] += hv * wb.x; lg[5] += hv * wb.y; lg[6] += hv * wb.z; lg[7] += hv * wb.w; }
                const float* br = a.in[31];
#pragma unroll
                for (int e = 0; e < 8; ++e) lg[e] = wave_sum(lg[e]) + br[e];
                int e0 = 0; float l0 = lg[0];
#pragma unroll
                for (int e = 1; e < 8; ++e) if (lg[e] > l0) { l0 = lg[e]; e0 = e; }
                int e1 = -1; float l1 = -INFINITY;
#pragma unroll
                for (int e = 0; e < 8; ++e) if (e != e0 && lg[e] > l1) { l1 = lg[e]; e1 = e; }
                const float w0 = 1.0f / (1.0f + __expf(l1 - l0));
                if (lane == i) { me0 = e0; me1 = e1; mw0 = w0; mw1 = 1.0f - w0; }
            }
        }
        if (ROUTE) {
            gu32* cnt = F.ctl + CW_CNT; int* perm = (int*)(a.ws + WS_PERM); int* tokslot = (int*)(a.ws + WS_TOKSLOT); float* tokw = (float*)(a.ws + WS_TOKW);
#pragma unroll 1
            for (int e = 0; e < NEXP; ++e) {
                const bool has = (lane < 16) && (me0 == e || me1 == e);
                const unsigned long long mask = __ballot(has); const int n = __popcll(mask);
                if (n) { unsigned base = 0u; if (lane == 0) base = __hip_atomic_fetch_add(cnt + 64 * e, (unsigned)n, RLX_AGENT); base = (unsigned)__shfl((int)base, 0);
                    if (has) { const int rank = (int)base + __popcll(mask & ((1ull << lane) - 1ull)); const int k = (me0 == e) ? 0 : 1; const int tok = m0 + lane;
                        perm[(size_t)e * M + rank] = tok; tokslot[2 * tok + k] = e * 32768 + rank; tokw[2 * tok + k] = k ? mw1 : mw0; } }
            }
        }
    }
    if (ROUTE) __syncthreads();
}

__device__ __forceinline__ void p11_spatial(Frame& F, const Args& a) {
    typedef float f32x16 __attribute__((ext_vector_type(16))); typedef float f32x2v __attribute__((ext_vector_type(2)));
    unsigned char* ws = a.ws;
    const bf16* VT = (const bf16*)(ws + WS_VT); const bf16* U = (const bf16*)(ws + WS_U); const bf16* WSB = (const bf16*)(ws + WS_WSB); bf16* GM = (bf16*)(ws + WS_GM);
    const float* gv = a.in[23]; const float* bv = a.in[24]; const float* bs = a.in[26];
    const int lane = F.lane, g = F.wave, l32 = lane & 31, hi = lane >> 5;
    LAS f32x2v* part = (LAS f32x2v*)(F.lds + RING_OFF);
    LAS f32x2v* stat = (LAS f32x2v*)(F.lds + RING_OFF + 8192);
    for (int ch = F.vcu; ch < NCHUNK; ch += F.G) {
        const bf16* vt = VT + (size_t)ch * DM * 128;
        { float s[8], q[8];
#pragma unroll
          for (int e = 0; e < 8; ++e) { s[e] = 0.f; q[e] = 0.f; }
#pragma unroll 4
          for (int it = 0; it < 32; ++it) { const int c = 128 * g + 4 * it + (lane >> 4); float v[8]; unpack8(*(const GAS v4u*)(vt + (size_t)c * 128 + 8 * (lane & 15)), v);
#pragma unroll
              for (int e = 0; e < 8; ++e) { s[e] += v[e]; q[e] += v[e] * v[e]; } }
#pragma unroll
          for (int e = 0; e < 8; ++e) { s[e] += __shfl_xor(s[e], 16); s[e] += __shfl_xor(s[e], 32); q[e] += __shfl_xor(q[e], 16); q[e] += __shfl_xor(q[e], 32); }
          if (lane < 16) {
#pragma unroll
              for (int e = 0; e < 8; ++e) part[g * 128 + 8 * lane + e] = (f32x2v){s[e], q[e]}; } }
        __syncthreads();
        if (F.tid < 128) { float s = 0.f, q = 0.f;
#pragma unroll
            for (int w = 0; w < 8; ++w) { const f32x2v p = part[w * 128 + F.tid]; s += p.x; q += p.y; }
            const float mu = s * (1.0f / DM); const float var = fmaxf(q * (1.0f / DM) - mu * mu, 0.f); stat[F.tid] = (f32x2v){mu, rsqrtf(var + EPS)}; }
        __syncthreads();
        const bf16* wg = WSB + (size_t)g * 128 * 128;
#pragma unroll 1
        for (int nt = 0; nt < 4; ++nt) {
            f32x16 acc[4];
#pragma unroll
            for (int mt = 0; mt < 4; ++mt)
#pragma unroll
                for (int r = 0; r < 16; ++r) acc[mt][r] = 0.f;
            const int c = 128 * g + 32 * nt + l32; const float gvc = gv[c], bvc = bv[c];
            const bf16* vc = vt + (size_t)c * 128;
#pragma unroll 1
            for (int ks = 0; ks < 8; ++ks) {
                const int q0 = 16 * ks + 8 * hi;
                bf16x8 af[4];
#pragma unroll
                for (int mt = 0; mt < 4; ++mt) af[mt] = *(const GAS bf16x8*)(wg + (size_t)(32 * mt + l32) * 128 + q0);
                float v[8]; unpack8(*(const GAS v4u*)(vc + q0), v);
#pragma unroll
                for (int e = 0; e < 8; ++e) { const f32x2v st = stat[q0 + e]; v[e] = (v[e] - st.x) * st.y * gvc + bvc; }
                const v4u pk = pack8(v); const bf16x8 bfr = __builtin_bit_cast(bf16x8, pk);
#pragma unroll
                for (int mt = 0; mt < 4; ++mt) acc[mt] = __builtin_amdgcn_mfma_f32_32x32x16_bf16(af[mt], bfr, acc[mt], 0, 0, 0);
            }
#pragma unroll
            for (int mt = 0; mt < 4; ++mt) {
#pragma unroll
                for (int r = 0; r < 16; ++r) { const int p = 32 * mt + (r & 3) + 8 * (r >> 2) + 4 * hi; const size_t off = ((size_t)ch * 128 + p) * DM + c;
                    const float uu = bf_lo((unsigned)U[off]); const float sv = acc[mt][r] + bs[g * 128 + p]; GM[off] = (bf16)f2bf(uu * sv);
                    if ((r & 3) == 3) asm volatile("" ::: "memory"); } }
        }
        __syncthreads();
    }
}

__device__ __forceinline__ void moe_tables(Frame& F) {
    LAS int* mt = (LAS int*)(F.lds + MOE_OFF);
    if (F.tid < NEXP) mt[F.tid] = (int)__hip_atomic_load(F.ctl + CW_CNT + 64 * F.tid, RLX_AGENT);
    __syncthreads();
    if (F.tid == 0) { int off = 0;
        for (int e = 0; e < NEXP; ++e) { mt[8 + e] = off; const int n = (mt[e] + 255) >> 8; for (int t = 0; t < n && off + t < 272; ++t) mt[32 + off + t] = e; off += n; }
        mt[16] = off; mt[24] = off < 272 ? off : 272; }
    __syncthreads();
}
__device__ __forceinline__ void p15_final(Frame& F, const Args& a) {
    const float* modv = (const float*)(a.ws + WS_MODV); const bf16* OSL = (const bf16*)(a.ws + WS_OSL); const int* tokslot = (const int*)(a.ws + WS_TOKSLOT); const float* tokw = (const float*)(a.ws + WS_TOKW);
    const LAS int* mt = (const LAS int*)(F.lds + MOE_OFF);
    const int lane = F.lane, gw = F.vcu * NWAVES + F.wave, NGW = F.G * NWAVES;
    for (int blk = gw; blk < M / 16; blk += NGW) { const int m0 = blk * 16, b = m0 / SEQ;
        f32x4 gg[4];
        { f32x4 gt[4], gp[4]; ld_row_f32(modp(modv, 1, b, 5), lane, gt); ld_row_f32(a.in[29], lane, gp);
#pragma unroll
          for (int k = 0; k < 4; ++k) gg[k] = gt[k] * gp[k]; }
        for (int i = 0; i < 16; ++i) { const size_t m = (size_t)(m0 + i);
            const int s0 = tokslot[2 * m], s1 = tokslot[2 * m + 1]; const float w0 = tokw[2 * m], w1 = tokw[2 * m + 1];
            const size_t r0 = (size_t)mt[8 + (s0 >> 15)] * 256 + (s0 & 32767), r1 = (size_t)mt[8 + (s1 >> 15)] * 256 + (s1 & 32767);
            f32x4 x[4], f0[4], f1[4]; ld_row_f32(a.out + m * DM, lane, x); ld_row_bf16(OSL + r0 * DM, lane, f0); ld_row_bf16(OSL + r1 * DM, lane, f1);
#pragma unroll
            for (int j = 0; j < 4; ++j) f0[j] = f0[j] * w0 + f1[j] * w1;
            const float ss = wave_sum((sq4(f0[0]) + sq4(f0[1])) + (sq4(f0[2]) + sq4(f0[3])));
            const float rf = rsqrtf(ss * (1.0f / DM) + EPS);
#pragma unroll
            for (int j = 0; j < 4; ++j) x[j] = x[j] + gg[j] * (f0[j] * rf);
            st_row_f32(a.out + m * DM, lane, x);
        }
    }
}

__global__ void __launch_bounds__(NWAVES * 64, 2) mk_fwd(Args args) {
    extern __shared__ __attribute__((aligned(16))) unsigned char lds[];
    Frame F;
    F.lds = (LAS unsigned char*)lds;
    F.MISC = (volatile LAS unsigned*)(F.lds + MISC_OFF);
    F.tid = threadIdx.x; F.lane = F.tid & 63; F.wave = __builtin_amdgcn_readfirstlane(F.tid >> 6);
    F.G = gridDim.x; { const int bx = blockIdx.x; F.vcu = (F.G % 8 == 0) ? (bx % 8) * (F.G / 8) + bx / 8 : bx; }
    unsigned char* ws = args.ws;
    F.ctl = (gu32*)(ws + WS_CTL);
    for (int u = F.tid; u < (LDS_BYTES - LDSCTL_OFF) / 4; u += NWAVES * 64) ((LAS unsigned*)(F.lds + LDSCTL_OFF))[u] = 0u;
    __syncthreads();
    const int lo = args.ph_lo, hi = args.ph_hi;
    XcdBarrier bar; bar.bar = (unsigned*)(F.ctl + CW_BAR); bar.x = 0; bar.st = nullptr;
    if (hi - lo > 1 || (lo <= 14 && 14 < hi)) bar = xcd_barrier_post((unsigned*)(F.ctl + CW_BAR), F.MISC + 8);
#ifndef PH_MASK
#define PH_MASK 0xFFFF
#endif
#define IN(k) ((((PH_MASK) >> (k)) & 1) && lo <= (k) && (k) < hi)
#define BOTH(k) (IN(k) && IN((k) + 1))
#define GRID_BAR() xcd_barrier(bar)
    PG8_LAS unsigned char* ring = F.lds + RING_OFF;
    const int cb = (int)blockIdx.x;

    if (IN(0)) { p0_prologue(F, args); if (BOTH(0)) GRID_BAR(); }
    if (IN(1)) { p1_prenorm(F, args); if (BOTH(1)) GRID_BAR(); }
    if (IN(2)) {
        pg8::Gemm g{(const pg8::bf16_t*)(ws + WS_HX), (const pg8::bf16_t*)(ws + WS_WIN), MA, NIN, DM}; pg8::InProjOrder S{M / 256, NIN / 256, MC / 256, 2, F.G, cb};
        pg8::EpiBf16<0> E{(pg8::bf16_t*)(ws + WS_QKV), NIN, 0, 0};
        pg8::gemm_phase<pg8::EpiBf16<0>, pg8::InProjOrder, true, false, false>(ring, g, S, E, nullptr);
        if (BOTH(2)) GRID_BAR(); }
    if (IN(3)) { p3_qkv_post(F, args); if (BOTH(3)) GRID_BAR(); }
    if (IN(4)) {
        const attn_body::AttnTensors AT{(const attn_body::bf16*)(ws + WS_Q), (const attn_body::bf16*)(ws + WS_KALL), (const attn_body::bf16*)(ws + WS_VALL), (attn_body::bf16*)(ws + WS_AC)};
        const attn_body::StaticOrder S((int)F.G, cb);
        attn_body::attn_phase<8>((char*)lds + RING_OFF, AT, S);
        if (BOTH(4)) GRID_BAR(); }
    if (IN(5)) {
        pg8::Gemm g{(const pg8::bf16_t*)(ws + WS_AC), (const pg8::bf16_t*)(ws + WS_WOUT), M, DM, DM}; pg8::GridOrder S{M / 256, DM / 256, F.G, cb};
        pg8::EpiBf16<0> E{(pg8::bf16_t*)(ws + WS_Y), DM, 0, 0};
        pg8::gemm_phase<pg8::EpiBf16<0>, pg8::GridOrder, true, false, false>(ring, g, S, E, nullptr);
        if (BOTH(5)) GRID_BAR(); }
    if (IN(6)) { rows_update<false>(F, args, args.in[0], (const bf16*)(ws + WS_Y), 0, 2, args.in[7], 0, 3, 4, args.in[13], (bf16*)(ws + WS_H2)); if (BOTH(6)) GRID_BAR(); }
    if (IN(7)) {
        pg8::Gemm g{(const pg8::bf16_t*)(ws + WS_H2), (const pg8::bf16_t*)(ws + WS_WGU), M, 2 * DFF, DM}; pg8::GridOrder S{M / 256, 2 * DFF / 256, F.G, cb};
        pg8::EpiSwiGLU E{(pg8::bf16_t*)(ws + WS_HID), DFF, 0, 0};
        pg8::gemm_phase<pg8::EpiSwiGLU, pg8::GridOrder, true, false, false>(ring, g, S, E, nullptr);
        if (BOTH(7)) GRID_BAR(); }
    if (IN(8)) {
        pg8::Gemm g{(const pg8::bf16_t*)(ws + WS_HID), (const pg8::bf16_t*)(ws + WS_WD), M, DM, DFF}; pg8::GridOrder S{M / 256, DM / 256, F.G, cb};
        pg8::EpiBf16<0> E{(pg8::bf16_t*)(ws + WS_Y), DM, 0, 0};
        pg8::gemm_phase<pg8::EpiBf16<0>, pg8::GridOrder, true, false, false>(ring, g, S, E, nullptr);
        if (BOTH(8)) GRID_BAR(); }
    if (IN(9)) { rows_update<false>(F, args, args.out, (const bf16*)(ws + WS_Y), 0, 5, args.in[14], 1, 0, 1, args.in[20], (bf16*)(ws + WS_H2)); if (BOTH(9)) GRID_BAR(); }
    if (IN(10)) {
        { pg8::Gemm g{(const pg8::bf16_t*)(ws + WS_H2), (const pg8::bf16_t*)(ws + WS_WGIN), M, DM, DM}; pg8::GridOrder S{M / 256, DM / 256, F.G, cb};
          pg8::EpiBf16<1> E{(pg8::bf16_t*)(ws + WS_U), DM, 0, 0};
          pg8::gemm_phase<pg8::EpiBf16<1>, pg8::GridOrder, true, false, false>(ring, g, S, E, nullptr); }
        { pg8::Gemm g{(const pg8::bf16_t*)(ws + WS_H2), (const pg8::bf16_t*)(ws + WS_WGIN) + (size_t)DM * DM, M, DM, DM}; pg8::GridOrder S{M / 256, DM / 256, F.G, cb};
          pg8::EpiGeluT E{(pg8::bf16_t*)(ws + WS_VT), DM};
          pg8::gemm_phase<pg8::EpiGeluT, pg8::GridOrder, true, true, false>(ring, g, S, E, nullptr); }
        if (BOTH(10)) GRID_BAR(); }
    if (IN(11)) { p11_spatial(F, args); if (BOTH(11)) GRID_BAR(); }
    if (IN(12)) {
        pg8::Gemm g{(const pg8::bf16_t*)(ws + WS_GM), (const pg8::bf16_t*)(ws + WS_WGOUT), M, DM, DM}; pg8::GridOrder S{M / 256, DM / 256, F.G, cb};
        pg8::EpiBf16<0> E{(pg8::bf16_t*)(ws + WS_Y), DM, 0, 0};
        pg8::gemm_phase<pg8::EpiBf16<0>, pg8::GridOrder, true, false, false>(ring, g, S, E, nullptr);
        if (BOTH(12)) GRID_BAR(); }
    if (IN(13)) { rows_update<true>(F, args, args.out, (const bf16*)(ws + WS_Y), 1, 2, args.in[21], 1, 3, 4, args.in[28], (bf16*)(ws + WS_H4)); if (BOTH(13)) GRID_BAR(); }
    if (IN(14)) {
        moe_tables(F);
        const PG8_LAS int* mt = (const PG8_LAS int*)(F.lds + MOE_OFF); PG8_LAS int* idx = (PG8_LAS int*)(F.lds + IDX_OFF);
        const int T = mt[24]; const int* perm = (const int*)(ws + WS_PERM);
#pragma unroll 1
        for (int tile0 = 0; tile0 < T; tile0 += 64) { const int nM = (T - tile0) < 64 ? (T - tile0) : 64;
            { pg8::MoeOrder S{nM, 2 * EFF / 256, F.G, cb, tile0, mt + 32};
              for (int i = 0; i < 8; ++i) { pg8::Unit u; if (!S.next(i, u)) break;
                  if (F.tid < 256) { const int tl = tile0 + u.pm, e = mt[32 + tl], cn = mt[e]; int rank = (tl - mt[8 + e]) * 256 + F.tid; if (rank >= cn) rank = cn - 1; idx[i * 256 + F.tid] = perm[(size_t)e * M + rank]; } }
              __syncthreads();
              pg8::Gemm g{(const pg8::bf16_t*)(ws + WS_H4), (const pg8::bf16_t*)(ws + WS_WEGU), M, 2 * EFF, DM};
              pg8::EpiSwiGLU E{(pg8::bf16_t*)(ws + WS_HIDE), EFF, 2 * EFF / 256, 0};
              pg8::gemm_phase<pg8::EpiSwiGLU, pg8::MoeOrder, true, false, true>(ring, g, S, E, idx); }
            GRID_BAR();
            { pg8::MoeOrder S{nM, DM / 256, F.G, cb, tile0, mt + 32};
              pg8::Gemm g{(const pg8::bf16_t*)(ws + WS_HIDE), (const pg8::bf16_t*)(ws + WS_WED), 64 * 256, DM, EFF};
              pg8::EpiBf16<0> E{(pg8::bf16_t*)(ws + WS_OSL), DM, DM / 256, tile0 * 256};
              pg8::gemm_phase<pg8::EpiBf16<0>, pg8::MoeOrder, true, false, false>(ring, g, S, E, nullptr); }
            GRID_BAR();
        }
    }
    if (IN(15)) { if (!IN(14)) moe_tables(F); p15_final(F, args); }
#undef IN
#undef BOTH
#undef GRID_BAR
}

extern "C" void kernel_launch(void* const* d_in, const int* in_sizes, int n_in, void* d_out, int out_size, void* d_ws, size_t ws_size, hipStream_t stream) {
    static int grid = 0;
    if (grid == 0) {
        if (n_in != 35 || in_sizes[0] != M * DM || out_size != M * DM || ws_size < WS_END) { fprintf(stderr, "kernel_launch: unexpected shapes / workspace (%d inputs, ws %zu, need %zu); nothing launched\n", n_in, ws_size, (size_t)WS_END); grid = -1; return; }
        int dev = 0, cus = 0;
        if (hipGetDevice(&dev) != hipSuccess || hipDeviceGetAttribute(&cus, hipDeviceAttributeMultiprocessorCount, dev) != hipSuccess) { grid = -1; return; }
        if (hipFuncSetAttribute((const void*)mk_fwd, hipFuncAttributeMaxDynamicSharedMemorySize, LDS_BYTES) != hipSuccess) { fprintf(stderr, "kernel_launch: hipFuncSetAttribute failed\n"); grid = -1; return; }
        int per_cu = 0;
        if (hipOccupancyMaxActiveBlocksPerMultiprocessor(&per_cu, (const void*)mk_fwd, NWAVES * 64, LDS_BYTES) != hipSuccess || per_cu < 1) fprintf(stderr, "kernel_launch: note: occupancy query reports %d workgroups per CU\n", per_cu);
        (void)hipGetLastError();
        grid = cus;
    }
    if (grid < 0) return;
    if (hipMemsetAsync((char*)d_ws + WS_CTL, 0, CTL_ZERO_BYTES, stream) != hipSuccess) return;
    Args a{};
    for (int i = 0; i < 35; ++i) a.in[i] = (const float*)d_in[i];
    a.out = (float*)d_out; a.ws = (unsigned char*)d_ws;
#if MK_PER_PHASE
    for (int p = 0; p < N_PHASES; ++p) { a.ph_lo = p; a.ph_hi = p + 1; hipLaunchKernelGGL(mk_fwd, dim3(grid), dim3(NWAVES * 64), LDS_BYTES, stream, a); }
#else
    a.ph_lo = 0; a.ph_hi = N_PHASES;
    hipLaunchKernelGGL(mk_fwd, dim3(grid), dim3(NWAVES * 64), LDS_BYTES, stream, a);
#endif
}
```

```cpp
#include <hip/hip_runtime.h>
#include <cstdio>
#include <cstdint>
namespace pg8 {
#define PG8_LAS __attribute__((address_space(3)))
typedef unsigned short bf16_t;
typedef short bf16x8 __attribute__((ext_vector_type(8)));
typedef float f32x4 __attribute__((ext_vector_type(4)));
typedef unsigned u32x4 __attribute__((ext_vector_type(4)));
constexpr int BM = 256, BK = 64, HALF = 128, HTB = HALF * BK * 2  , STAGE_BYTES = 8 * HTB, NXCD = 8, WGM = 8;

__host__ __device__ __forceinline__ int lds_byte(int r, int c) { const int st = (r >> 4) * 2 + (c >> 5), rr = r & 15, cc = c & 31, ob = rr * 64 + cc * 2; return st * 1024 + (ob ^ (((ob >> 9) & 1) << 5)); }
__host__ __device__ __forceinline__ void stage_rc(int b, int& R, int& C) { const int st = b / 1024, sb = b % 1024, swz = sb ^ (((sb >> 9) & 1) << 5); R = (st >> 1) * 16 + swz / 64; C = (st & 1) * 32 + (swz % 64) / 2; }
__host__ __device__ __forceinline__ int perm32(int rho) { const int n = rho >> 4, i = rho & 15; return 8 * (i >> 2) + 4 * n + (i & 3); }

struct Unit { int pm, pn; };
struct Gemm { const bf16_t* A; const bf16_t* Bt; int M, N, K; };

struct StaticOrder {
    int nM, nN, nwg, G, c;
    __host__ __device__ void init(int M, int N, int G_, int c_) { nM = M / BM; nN = N / BM; nwg = nM * nN; G = G_; c = c_; }
    __host__ __device__ bool next(int i, Unit& u) const {
        const long L = (long)i * G + c; if (L >= nwg) return false;
        int wgid = (int)L; { const int q = nwg / NXCD, r = nwg % NXCD, xcd = wgid % NXCD, off = wgid / NXCD; wgid = (xcd < r ? xcd * (q + 1) : r * (q + 1) + (xcd - r) * q) + off; }
        const int nig = WGM * nN, gid = wgid / nig, fm = gid * WGM, gsz = (nM - fm) < WGM ? (nM - fm) : WGM;
        u.pm = fm + ((wgid % nig) % gsz); u.pn = (wgid % nig) / gsz; return true;
    }
    __device__ __forceinline__ void a_ready(const Unit&) const {}
    __device__ __forceinline__ void done(const Unit&) const {}
};


__device__ __forceinline__ void map_tile(int L, int nM, int nN, int& pm, int& pn) {
    const int nwg = nM * nN; int wgid = L;
    { const int q = nwg / NXCD, r = nwg % NXCD, xcd = wgid % NXCD, off = wgid / NXCD; wgid = (xcd < r ? xcd * (q + 1) : r * (q + 1) + (xcd - r) * q) + off; }
    const int nig = WGM * nN, gid = wgid / nig, fm = gid * WGM, gsz = (nM - fm) < WGM ? (nM - fm) : WGM;
    pm = fm + ((wgid % nig) % gsz); pn = (wgid % nig) / gsz;
}

__device__ __forceinline__ unsigned cvt_pk_bf16(float lo, float hi) { unsigned r; asm volatile("v_cvt_pk_bf16_f32 %0, %1, %2" : "=v"(r) : "v"(lo), "v"(hi)); return r; }

__device__ __forceinline__ float gelu_tanh_f(float x) {
    const float z2 = x * (1.5957691216f + 0.0713548163f * x * x);
    return x * __builtin_amdgcn_rcpf(1.0f + __builtin_amdgcn_exp2f(-1.4426950409f * z2));
}
__device__ __forceinline__ float silu_f(float x) { return x * __builtin_amdgcn_rcpf(1.0f + __builtin_amdgcn_exp2f(-1.4426950409f * x)); }

template <int ACT> struct EpiBf16 {
    static constexpr bool PERM = true, AFTER_DRAIN = false;
    bf16_t* O; int ldc; int pn_mod; int rowoff;
    __device__ __forceinline__ void operator()(const f32x4 (&acc)[2][2][4][2], const Unit& u, int wr, int wc, int fr, int fq) const {
        const int row0 = rowoff + u.pm * BM + wr * 64 + fr; const int colt = (pn_mod ? (u.pn % pn_mod) : u.pn) * BM;
        const int col0 = colt + wc * 32 + 8 * fq;
#pragma unroll
        for (int ai = 0; ai < 2; ++ai)
#pragma unroll
            for (int m = 0; m < 4; ++m) { bf16_t* rowp = O + (size_t)(row0 + ai * HALF + m * 16) * ldc + col0;
#pragma unroll
                for (int bj = 0; bj < 2; ++bj) { f32x4 v0 = acc[ai][bj][m][0], v1 = acc[ai][bj][m][1];
                    if (ACT == 1) { v0 = (f32x4){gelu_tanh_f(v0[0]), gelu_tanh_f(v0[1]), gelu_tanh_f(v0[2]), gelu_tanh_f(v0[3])}; v1 = (f32x4){gelu_tanh_f(v1[0]), gelu_tanh_f(v1[1]), gelu_tanh_f(v1[2]), gelu_tanh_f(v1[3])}; }
                    u32x4 w; w.x = cvt_pk_bf16(v0[0], v0[1]); w.y = cvt_pk_bf16(v0[2], v0[3]); w.z = cvt_pk_bf16(v1[0], v1[1]); w.w = cvt_pk_bf16(v1[2], v1[3]);
                    *(u32x4*)(rowp + bj * HALF) = w; } }
    }
};
struct EpiSwiGLU {
    static constexpr bool PERM = true, AFTER_DRAIN = false;
    bf16_t* O; int ldc; int pn_mod; int rowoff;
    __device__ __forceinline__ void operator()(const f32x4 (&acc)[2][2][4][2], const Unit& u, int wr, int wc, int fr, int fq) const {
        const int row0 = rowoff + u.pm * BM + wr * 64 + fr; const int colt = (pn_mod ? (u.pn % pn_mod) : u.pn) * HALF;
        const int col0 = colt + wc * 32 + 8 * fq;
#pragma unroll
        for (int ai = 0; ai < 2; ++ai)
#pragma unroll
            for (int m = 0; m < 4; ++m) { bf16_t* rowp = O + (size_t)(row0 + ai * HALF + m * 16) * ldc + col0;
                const f32x4 g0 = acc[ai][0][m][0], g1 = acc[ai][0][m][1], u0 = acc[ai][1][m][0], u1 = acc[ai][1][m][1];
                u32x4 w; w.x = cvt_pk_bf16(silu_f(g0[0]) * u0[0], silu_f(g0[1]) * u0[1]); w.y = cvt_pk_bf16(silu_f(g0[2]) * u0[2], silu_f(g0[3]) * u0[3]);
                w.z = cvt_pk_bf16(silu_f(g1[0]) * u1[0], silu_f(g1[1]) * u1[1]); w.w = cvt_pk_bf16(silu_f(g1[2]) * u1[2], silu_f(g1[3]) * u1[3]);
                *(u32x4*)rowp = w; }
    }
};
struct EpiGeluT {
    static constexpr bool PERM = false, AFTER_DRAIN = false;
    bf16_t* VT; int nch;
    __device__ __forceinline__ void operator()(const f32x4 (&acc)[2][2][4][2], const Unit& u, int wr, int wc, int fr, int fq) const {
        typedef unsigned u32x2v __attribute__((ext_vector_type(2)));
#pragma unroll
        for (int ai = 0; ai < 2; ++ai) { const int chunk = 2 * u.pm + ai;
#pragma unroll
            for (int bj = 0; bj < 2; ++bj)
#pragma unroll
                for (int n = 0; n < 2; ++n) { const int ch = u.pn * BM + bj * HALF + wc * 32 + n * 16 + fr; bf16_t* cp = VT + ((size_t)chunk * nch + ch) * 128 + wr * 64 + 4 * fq;
#pragma unroll
                    for (int m = 0; m < 4; ++m) { const f32x4 v = acc[ai][bj][m][n]; u32x2v w; w.x = cvt_pk_bf16(gelu_tanh_f(v[0]), gelu_tanh_f(v[1])); w.y = cvt_pk_bf16(gelu_tanh_f(v[2]), gelu_tanh_f(v[3]));
                        *(u32x2v*)(cp + m * 16) = w; } } }
    }
};


struct GridOrder {
    int nM, nN, G, c;
    __device__ __forceinline__ bool next(int i, Unit& u) const { const int L = i * G + c; if (L >= nM * nN) return false; map_tile(L, nM, nN, u.pm, u.pn); return true; }
    __device__ __forceinline__ void a_ready(const Unit&) const {}
    __device__ __forceinline__ void done(const Unit&) const {}
};
struct InProjOrder {
    int nM, nN, nX, pnX, G, c;
    __device__ __forceinline__ bool next(int i, Unit& u) const { const int L = i * G + c, n0 = nM * nN; if (L < n0) { map_tile(L, nM, nN, u.pm, u.pn); return true; } if (L < n0 + nX) { u.pm = nM + (L - n0); u.pn = pnX; return true; } return false; }
    __device__ __forceinline__ void a_ready(const Unit&) const {}
    __device__ __forceinline__ void done(const Unit&) const {}
};
struct MoeOrder {
    int nM, nN, G, c, tile0; const PG8_LAS int* tile_e;
    __device__ __forceinline__ bool next(int i, Unit& u) const { const int L = i * G + c; if (L >= nM * nN) return false; int pm, pn; map_tile(L, nM, nN, pm, pn); u.pm = pm; u.pn = tile_e[tile0 + pm] * nN + pn; return true; }
    __device__ __forceinline__ void a_ready(const Unit&) const {}
    __device__ __forceinline__ void done(const Unit&) const {}
};
template <class Epi, class Sched, bool ALIGN_EPI, bool SWAP, bool GATHER>
__device__ __forceinline__ void gemm_phase(PG8_LAS unsigned char* lds, const Gemm g, const Sched& S, const Epi& E, const PG8_LAS int* idxtab) {
    const int tid = threadIdx.x, wid = __builtin_amdgcn_readfirstlane(tid >> 6), lane = tid & 63, wr = wid >> 2, wc = wid & 3, fr = lane & 15, fq = lane >> 4;
    const int K = g.K, nt = K / BK;
    unsigned voffB[2], vc0[2], vc1[2], vn0[2], vn1[2]; int RA[2], CA[2];
#pragma unroll
    for (int i = 0; i < 2; ++i) { int R, C; stage_rc(tid * 16 + i * 8192, R, C); const int Rb = Epi::PERM ? ((R & ~31) + perm32(R & 31)) : R;
        RA[i] = R; CA[i] = C; voffB[i] = (unsigned)(Rb * K + C) * 2u; vc0[i] = vc1[i] = vn0[i] = vn1[i] = (unsigned)(R * K + C) * 2u; }
    const size_t kstep = (size_t)(BK * 2);
    const size_t hstep = (size_t)HALF * K * 2;
    const size_t tstep = 2 * hstep;
    const size_t hstepA = GATHER ? (size_t)0 : hstep;
    const unsigned ldsw = (unsigned)wid * 1024u;
    const int aoff = lds_byte(wr * 64 + fr, fq * 8), boff = lds_byte(wc * 32 + fr, fq * 8);
#define PG8_SA(b, h) (((b) * 2 + (h)) * HTB)
#define PG8_SB(b, h) ((4 + (b) * 2 + (h)) * HTB)
#define PG8_STAGE(bufoff, gbase, voff) do { _Pragma("unroll") for (int _i = 0; _i < 2; ++_i) \
        __builtin_amdgcn_global_load_lds((const unsigned*)((const char*)(gbase) + (voff)[_i]), (PG8_LAS unsigned*)(lds + (bufoff) + ldsw + _i * 8192), 16, 0, 0); } while (0)
#define PG8_LDA(dst, b, h) do { _Pragma("unroll") for (int m = 0; m < 4; ++m) _Pragma("unroll") for (int k = 0; k < 2; ++k) dst[m][k] = *(const PG8_LAS bf16x8*)(lds + PG8_SA(b, h) + aoff + m * 2048 + k * 1024); } while (0)
#define PG8_LDB(dst, b, h) do { _Pragma("unroll") for (int n = 0; n < 2; ++n) _Pragma("unroll") for (int k = 0; k < 2; ++k) dst[n][k] = *(const PG8_LAS bf16x8*)(lds + PG8_SB(b, h) + boff + n * 2048 + k * 1024); } while (0)
#define PG8_MMA(ai, bj, At, Bt) do { __builtin_amdgcn_s_setprio(1); _Pragma("unroll") for (int m = 0; m < 4; ++m) _Pragma("unroll") for (int n = 0; n < 2; ++n) _Pragma("unroll") for (int k = 0; k < 2; ++k) \
        acc[ai][bj][m][n] = SWAP ? __builtin_amdgcn_mfma_f32_16x16x32_bf16(At[m][k], Bt[n][k], acc[ai][bj][m][n], 0, 0, 0) : __builtin_amdgcn_mfma_f32_16x16x32_bf16(Bt[n][k], At[m][k], acc[ai][bj][m][n], 0, 0, 0); __builtin_amdgcn_s_setprio(0); } while (0)
#define PG8_WAIT_V(n) asm volatile("s_waitcnt vmcnt(" #n ")" ::: "memory")
#define PG8_WAIT_L(n) asm volatile("s_waitcnt lgkmcnt(" #n ")" ::: "memory")
#define PG8_BAR __builtin_amdgcn_s_barrier()
#define PG8_SCHED __builtin_amdgcn_sched_barrier(0)
    Unit cur, nxt; int ui = 0;
    if (!S.next(0, cur)) return;
    if constexpr (GATHER) {
#pragma unroll
        for (int i = 0; i < 2; ++i) { vc0[i] = (unsigned)(idxtab[RA[i]] * K + CA[i]) * 2u; vc1[i] = (unsigned)(idxtab[HALF + RA[i]] * K + CA[i]) * 2u; vn0[i] = vc0[i]; vn1[i] = vc1[i]; }
    }
    f32x4 acc[2][2][4][2];
#pragma unroll
    for (int a = 0; a < 2; ++a)
#pragma unroll
        for (int b = 0; b < 2; ++b)
#pragma unroll
            for (int m = 0; m < 4; ++m)
#pragma unroll
                for (int n = 0; n < 2; ++n) acc[a][b][m][n] = (f32x4){0.f, 0.f, 0.f, 0.f};
    bf16x8 At[4][2], B0[2][2], B1[2][2];
    const char* cA = GATHER ? (const char*)g.A : (const char*)g.A + (size_t)cur.pm * tstep; const char* cB = (const char*)g.Bt + (size_t)cur.pn * tstep;
    S.a_ready(cur);
    PG8_STAGE(PG8_SB(0, 0), cB, voffB); PG8_STAGE(PG8_SB(0, 1), cB + hstep, voffB); PG8_STAGE(PG8_SA(0, 0), cA, vc0); PG8_STAGE(PG8_SA(0, 1), cA + hstepA, vc1);
    if (wr == 1) PG8_BAR;
    PG8_WAIT_V(2); PG8_BAR;
    PG8_STAGE(PG8_SB(1, 0), cB + kstep, voffB); PG8_STAGE(PG8_SA(1, 0), cA + kstep, vc0); PG8_STAGE(PG8_SB(1, 1), cB + hstep + kstep, voffB);
    PG8_WAIT_V(6); PG8_BAR;
    for (;;) {
        const bool has_next = S.next(ui + 1, nxt);
        if constexpr (GATHER) {
            if (has_next) {
#pragma unroll
                for (int i = 0; i < 2; ++i) { vn0[i] = (unsigned)(idxtab[(ui + 1) * BM + RA[i]] * K + CA[i]) * 2u; vn1[i] = (unsigned)(idxtab[(ui + 1) * BM + HALF + RA[i]] * K + CA[i]) * 2u; }
            }
        }
        const char* nA = GATHER ? cA : (has_next ? (const char*)g.A + (size_t)nxt.pm * tstep : cA); const char* nB = has_next ? (const char*)g.Bt + (size_t)nxt.pn * tstep : cB;
        for (int t = 0; t < nt; t += 2) {
            const bool last = (t == nt - 2);
            const char* a1 = cA + (size_t)(t + 1) * kstep;
            const char* a2 = last ? nA : cA + (size_t)(t + 2) * kstep; const char* b2 = last ? nB : cB + (size_t)(t + 2) * kstep;
            const char* a3 = a2 + kstep; const char* b3 = b2 + kstep;
            unsigned w0[2], w1[2];
#pragma unroll
            for (int i = 0; i < 2; ++i) { w0[i] = (GATHER && last) ? vn0[i] : vc0[i]; w1[i] = (GATHER && last) ? vn1[i] : vc1[i]; }
            if (last && has_next) S.a_ready(nxt);
            PG8_LDB(B0, 0, 0); PG8_LDB(B1, 0, 1); PG8_SCHED; PG8_LDA(At, 0, 0); PG8_STAGE(PG8_SA(1, 1), a1 + hstepA, vc1);
            PG8_WAIT_V(8); PG8_WAIT_L(0); PG8_BAR; PG8_MMA(0, 0, At, B0); PG8_MMA(0, 1, At, B1); PG8_BAR; PG8_SCHED;
            PG8_LDA(At, 0, 1); PG8_STAGE(PG8_SB(0, 0), b2, voffB); PG8_STAGE(PG8_SB(0, 1), b2 + hstep, voffB); PG8_STAGE(PG8_SA(0, 0), a2, w0);
            PG8_WAIT_V(8); PG8_WAIT_L(0); PG8_BAR; PG8_MMA(1, 0, At, B0); PG8_MMA(1, 1, At, B1); PG8_BAR; PG8_SCHED;
            PG8_LDB(B0, 1, 0); PG8_LDB(B1, 1, 1); PG8_SCHED; PG8_LDA(At, 1, 0); PG8_STAGE(PG8_SA(0, 1), a2 + hstepA, w1);
            PG8_WAIT_V(8); PG8_WAIT_L(0); PG8_BAR; PG8_MMA(0, 0, At, B0); PG8_MMA(0, 1, At, B1); PG8_BAR; PG8_SCHED;
            PG8_LDA(At, 1, 1); PG8_STAGE(PG8_SB(1, 0), b3, voffB); PG8_STAGE(PG8_SB(1, 1), b3 + hstep, voffB); PG8_STAGE(PG8_SA(1, 0), a3, w0);
            PG8_WAIT_V(8); PG8_WAIT_L(0); PG8_BAR; PG8_MMA(1, 0, At, B0); PG8_MMA(1, 1, At, B1); PG8_BAR; PG8_SCHED;
        }
        if constexpr (ALIGN_EPI) { if (wr == 0) PG8_BAR; }
        E(acc, cur, wr, wc, fr, fq); S.done(cur);
        if (!has_next) break;
#pragma unroll
        for (int a = 0; a < 2; ++a)
#pragma unroll
            for (int b = 0; b < 2; ++b)
#pragma unroll
                for (int m = 0; m < 4; ++m)
#pragma unroll
                    for (int n = 0; n < 2; ++n) acc[a][b][m][n] = (f32x4){0.f, 0.f, 0.f, 0.f};
        cur = nxt; cA = nA; cB = nB; ++ui;
#pragma unroll
        for (int i = 0; i < 2; ++i) { vc0[i] = vn0[i]; vc1[i] = vn1[i]; }
        if constexpr (ALIGN_EPI) { if (wr == 1) PG8_BAR; }
    }
    PG8_WAIT_V(0);
    if constexpr (!ALIGN_EPI) { if (wr == 0) PG8_BAR; }
    PG8_BAR;
#undef PG8_SA
#undef PG8_SB
#undef PG8_STAGE
#undef PG8_LDA
#undef PG8_LDB
#undef PG8_MMA
#undef PG8_WAIT_V
#undef PG8_WAIT_L
#undef PG8_BAR
#undef PG8_SCHED
}
}
#include <hip/hip_bf16.h>
#include <cmath>
namespace attn_body {
using bf16=__hip_bfloat16;
using bf16x8=__attribute__((ext_vector_type(8)))short;
using s16x4=__attribute__((ext_vector_type(4)))short;
using f32x16=__attribute__((ext_vector_type(16)))float;
using u32x4=__attribute__((ext_vector_type(4)))unsigned;
constexpr int NHEAD=8,NKVH=2,SEQ=8192,SKV=8448,D=64,QP=512,KP=128,OP=1024;
constexpr int NW=8,QBLK=32,QB=QBLK*NW,KVBLK=64,NQB=SEQ/QB,NT=SKV/KVBLK;
constexpr int ATTN_UNIT_ROWS=QB;
__device__ __forceinline__ int crow(int r,int hi){return (r&3)+8*(r>>2)+4*hi;}
#define SBAR() __builtin_amdgcn_sched_barrier(0)
__device__ __forceinline__ void cmask(f32x16&p0,f32x16&p1,int jb,int qrel,int hi){
  const float NEG=-INFINITY; int kb=64*jb+4*hi;
  #pragma unroll
  for(int r=0;r<16;++r){int kv=kb+(r&3)+8*(r>>2); if(kv>qrel)p0[r]=NEG; if(kv+32>qrel)p1[r]=NEG;}
}

constexpr int NSLOT=3, SLOTB=8192;
constexpr int LDS_K=0, LDS_V=NSLOT*SLOTB, LDS_WS=2*NSLOT*SLOTB, LDS_OST=LDS_WS+NW*64*4, LDS_BYTES=LDS_OST+NW*4096;
constexpr float C2=0.125f*1.4426950408889634f;
__device__ __forceinline__ void glds16(const void*gsrc,unsigned lds_dst){unsigned keep;
  asm volatile("s_mov_b32 %0, m0\n\ts_mov_b32 m0, %2\n\ts_nop 0\n\tglobal_load_lds_dwordx4 %1, off\n\ts_mov_b32 m0, %0":"=&s"(keep):"v"(gsrc),"s"(lds_dst):"memory");}
__device__ __forceinline__ float max3f(float a,float b,float c){float r;asm("v_max3_f32 %0, %1, %2, %3":"=v"(r):"v"(a),"v"(b),"v"(c));return r;}
__device__ __forceinline__ float max2f(float a,float b){float r;asm("v_max_f32_e32 %0, %1, %2":"=v"(r):"v"(a),"v"(b));return r;}
__device__ __forceinline__ float fadd_s(float a,float b){float r;asm("v_add_f32_e32 %0, %1, %2":"=v"(r):"v"(a),"v"(b));return r;}
__device__ __forceinline__ float fsub_s(float a,float b){float r;asm("v_sub_f32_e32 %0, %1, %2":"=v"(r):"v"(a),"v"(b));return r;}
typedef float f32x2_t __attribute__((ext_vector_type(2))); typedef __bf16 bf16x2_t __attribute__((ext_vector_type(2)));
__device__ __forceinline__ unsigned cvtpk_s(float lo,float hi){f32x2_t v={lo,hi};bf16x2_t b=__builtin_convertvector(v,bf16x2_t);return __builtin_bit_cast(unsigned,b);}
#define WAIT_BAR(N) asm volatile("s_waitcnt vmcnt(" #N ") lgkmcnt(0)\n\ts_barrier":::"memory")

__device__ __forceinline__ void qkt(f32x16&p0,f32x16&p1,const char*Kslot,const bf16x8*qr,const f32x16&negm,int r32,int hi){
  const char*kb=Kslot+hi*1024+r32*16;
  #pragma unroll
  for(int d0=0;d0<4;++d0){
    const bf16x8 b0=*reinterpret_cast<const bf16x8*>(kb+d0*2048);
    const bf16x8 b1=*reinterpret_cast<const bf16x8*>(kb+d0*2048+512);
    if(d0==0){p0=__builtin_amdgcn_mfma_f32_32x32x16_bf16(b0,qr[0],negm,0,0,0);p1=__builtin_amdgcn_mfma_f32_32x32x16_bf16(b1,qr[0],negm,0,0,0);}
    else{p0=__builtin_amdgcn_mfma_f32_32x32x16_bf16(b0,qr[d0],p0,0,0,0);p1=__builtin_amdgcn_mfma_f32_32x32x16_bf16(b1,qr[d0],p1,0,0,0);}}
}
typedef __attribute__((address_space(3))) const char* lds_cptr;
typedef short v4i16_t __attribute__((ext_vector_type(4)));
__device__ __forceinline__ void kload8(bf16x8*kf,lds_cptr kp){
  kf[0]=*(const __attribute__((address_space(3))) bf16x8*)(kp);      kf[1]=*(const __attribute__((address_space(3))) bf16x8*)(kp+512);
  kf[2]=*(const __attribute__((address_space(3))) bf16x8*)(kp+2048); kf[3]=*(const __attribute__((address_space(3))) bf16x8*)(kp+2560);
  kf[4]=*(const __attribute__((address_space(3))) bf16x8*)(kp+4096); kf[5]=*(const __attribute__((address_space(3))) bf16x8*)(kp+4608);
  kf[6]=*(const __attribute__((address_space(3))) bf16x8*)(kp+6144); kf[7]=*(const __attribute__((address_space(3))) bf16x8*)(kp+6656);
}
__device__ __forceinline__ void kload2(bf16x8*kf,lds_cptr kp,int j){ kf[2*j]=*(const __attribute__((address_space(3))) bf16x8*)(kp+j*2048); kf[2*j+1]=*(const __attribute__((address_space(3))) bf16x8*)(kp+j*2048+512); }
__device__ __forceinline__ s16x4 vtr(lds_cptr p){ return __builtin_bit_cast(s16x4,__builtin_amdgcn_ds_read_tr16_b64_v4i16((__attribute__((address_space(3))) v4i16_t*)p)); }
__device__ __forceinline__ float rowmax(const f32x16&p0,const f32x16&p1){
  float a=max3f(p0[0],p0[1],p1[0]),b=max3f(p0[2],p0[3],p1[1]);a=max3f(a,p1[2],p1[3]);
  #pragma unroll
  for(int r=4;r<16;r+=4){a=max3f(a,p0[r],p0[r+1]);b=max3f(b,p0[r+2],p0[r+3]);a=max3f(a,p1[r],p1[r+1]);b=max3f(b,p1[r+2],p1[r+3]);}
  const float m=max2f(a,b);
  auto rr=__builtin_amdgcn_permlane32_swap(__float_as_uint(m),__float_as_uint(m),false,false);
  return max2f(__uint_as_float(rr[0]),__uint_as_float(rr[1]));
}
__device__ __forceinline__ void pv(f32x16*o,int vb,bf16x8 pa0,bf16x8 pa1,bf16x8 pa2,bf16x8 pa3){
  #pragma unroll
  for(int d0=0;d0<2;++d0){s16x4 lo[4],hi[4];
    #pragma unroll
    for(int ks=0;ks<4;++ks){
      asm volatile("ds_read_b64_tr_b16 %0,%1 offset:%c2":"=&v"(lo[ks]):"v"(vb),"i"(d0*4096+ks*1024):"memory");
      asm volatile("ds_read_b64_tr_b16 %0,%1 offset:%c2":"=&v"(hi[ks]):"v"(vb),"i"(d0*4096+ks*1024+512):"memory");}
    asm volatile("s_waitcnt lgkmcnt(0)":::"memory");SBAR();
    #define PK(k) (bf16x8){lo[k][0],lo[k][1],lo[k][2],lo[k][3],hi[k][0],hi[k][1],hi[k][2],hi[k][3]}
    o[d0]=__builtin_amdgcn_mfma_f32_32x32x16_bf16(pa0,PK(0),o[d0],0,0,0);
    o[d0]=__builtin_amdgcn_mfma_f32_32x32x16_bf16(pa1,PK(1),o[d0],0,0,0);
    o[d0]=__builtin_amdgcn_mfma_f32_32x32x16_bf16(pa2,PK(2),o[d0],0,0,0);
    o[d0]=__builtin_amdgcn_mfma_f32_32x32x16_bf16(pa3,PK(3),o[d0],0,0,0);
    #undef PK
  }
}

#ifndef ATTN_STORE16
#define ATTN_STORE16(p,v) (*(u32x4*)(p)=(v))
#endif
template<int THRL> __device__ __forceinline__ void attn_unit(int b,int h,int qb,const bf16*Q,const bf16*__restrict__ K,const bf16*__restrict__ V,bf16*O,char*shm){
  const int tid=threadIdx.x,lane=tid&63,r32=lane&31,hi=lane>>5; const int wid=__builtin_amdgcn_readfirstlane(tid>>6);
  const long rowbase=(long)b*SEQ; const int q0=qb*QB; const int kvh=h/(NHEAD/NKVH);
  const bf16*Qw=Q+(rowbase+q0+wid*QBLK)*QP+h*D;
  const bf16*Kh=K+(long)b*SKV*KP+kvh*D,*Vh=V+(long)b*SKV*KP+kvh*D;
  const unsigned lds0=(unsigned)(uintptr_t)shm;
  float*wsf=(float*)(shm+LDS_WS)+wid*64;
  const bf16*ksrc=Kh+(long)lane*KP+wid*8;
  const bf16*vsrc=Vh+(long)(16*(wid&3)+(lane>>2))*KP+(wid>>2)*32+(lane&3)*8;
  const unsigned kdst=lds0+LDS_K+wid*1024, vdst=lds0+LDS_V+wid*1024;
  #define DMA_K(t,slot) glds16(ksrc+(long)(t)*KVBLK*KP,(unsigned)__builtin_amdgcn_readfirstlane(kdst+(slot)))
  #define DMA_V(t,slot) glds16(vsrc+(long)(t)*KVBLK*KP,(unsigned)__builtin_amdgcn_readfirstlane(vdst+(slot)))
  const int vb0=(int)(lds0+LDS_V)+((lane>>4)&1)*32+(lane&3)*8+(4*hi+((lane&15)>>2))*64;
  const char*Kbase=shm+LDS_K; bf16x8 kf[8];
  const lds_cptr shm3=(lds_cptr)shm; const lds_cptr kp0=shm3+LDS_K+hi*1024+r32*16; const lds_cptr vp0=shm3+LDS_V+((lane>>4)&1)*32+(lane&3)*8+(4*hi+((lane&15)>>2))*64;
  DMA_K(0,0);DMA_V(0,0);DMA_K(1,SLOTB);
  bf16x8 qr[4];
  #pragma unroll
  for(int d0=0;d0<4;++d0)qr[d0]=*reinterpret_cast<const bf16x8*>(&Qw[(long)r32*QP+d0*16+hi*8]);
  float mhat=0.f,l_reg=0.f;f32x16 o[2];o[0]=f32x16{};o[1]=f32x16{};f32x16 negm=f32x16{};asm volatile("":"+v"(negm));
  #define CMASK(P0,P1,t) do{}while(0)
  bool resc=false;
  #define START(P0,P1) do{ const float rm=rowmax(P0,P1); resc=false; \
    { const float dl=rm; mhat=fadd_s(mhat,dl); \
      _Pragma("unroll") for(int r=0;r<16;++r){P0[r]=fsub_s(P0[r],dl);P1[r]=fsub_s(P1[r],dl);} \
      _Pragma("unroll") for(int r=0;r<16;++r)negm[r]=-mhat; asm volatile("":"+v"(negm)); } \
    _Pragma("unroll") for(int r=0;r<16;++r)P0[r]=__builtin_amdgcn_exp2f(P0[r]); }while(0)
  #define RESC() do{ if(resc){ asm volatile("s_waitcnt lgkmcnt(0)":::"memory"); \
      _Pragma("unroll") for(int d_=0;d_<2;++d_) _Pragma("unroll") for(int r=0;r<16;++r)o[d_][r]*=wsf[crow(r,hi)]; } }while(0)
  f32x16 pA0,pA1,pB0,pB1;
  int sl_prev=0,sl_cur=0,sl_next=SLOTB;
  #define ROT() do{sl_prev=sl_cur;sl_cur=sl_next;sl_next=(sl_next==(NSLOT-1)*SLOTB)?0:sl_next+SLOTB;}while(0)
  DMA_K(2,2*SLOTB);
  WAIT_BAR(3);
  qkt(pA0,pA1,Kbase,qr,negm,r32,hi);asm volatile("s_nop 15\n\ts_nop 7":"+v"(pA0),"+v"(pA1));CMASK(pA0,pA1,0);
  START(pA0,pA1);
  _Pragma("unroll") for(int r=0;r<16;++r)pA1[r]=__builtin_amdgcn_exp2f(pA1[r]);
  WAIT_BAR(0);
  DMA_K(3,0);DMA_V(1,SLOTB);
  ROT();
  kload8(kf,kp0+sl_cur);
  WAIT_BAR(2);
  s16x4 vlo[8],vhi[8]; u32x4 pw0,pw1,pw2,pw3;
  #define PKW(P,B) cvtpk_s(P[B],P[B+1])
  #define PAF(k) __builtin_bit_cast(bf16x8,pw##k)
  #define VFR(i) (bf16x8){vlo[i][0],vlo[i][1],vlo[i][2],vlo[i][3],vhi[i][0],vhi[i][1],vhi[i][2],vhi[i][3]}
  #define PIN(x) asm volatile("":"+v"(x))
  #define MX3(a,b,c) __builtin_fmaxf(__builtin_fmaxf((a),(b)),(c))
  #define GAPA(MF,A0,A1,A2,A3,W0,W1,PW) do{ MF; sacc+=A0; sacc+=A1; sacc+=A2; sacc+=A3; PIN(sacc); W0; W1; PIN(PW); SBAR(); }while(0)
  #define EX(v) __builtin_amdgcn_exp2f(v)
  #define GAPB(MF,X,B) do{ MF; X[B]=EX(X[B]); X[B+1]=EX(X[B+1]); X[B+2]=EX(X[B+2]); X[B+3]=EX(X[B+3]); PIN(X); SBAR(); }while(0)
  #define VRD(i) do{ vlo[i]=vtr(vp_+(((i)>>2)*4096+((i)&3)*1024)); vhi[i]=vtr(vp_+(((i)>>2)*4096+((i)&3)*1024+512)); }while(0)
  #define KRD(G,j) do{ if(G){ kload2(kf,kp0+sl_next,j); SBAR(); } }while(0)
  #define STEP(C0,C1,P0,P1,t,GK,GV,GL) do{ SBAR(); \
    const lds_cptr vp_=vp0+sl_prev; \
    VRD(0); SBAR(); float sacc=(P0[0]+P0[1]); \
    GAPA(C0=__builtin_amdgcn_mfma_f32_32x32x16_bf16(kf[0],qr[0],negm,0,0,0), P0[2],P0[3],P0[4],P0[5],     pw0[0]=PKW(P0,0), pw0[1]=PKW(P0,2), pw0); \
    VRD(4); SBAR(); GAPA(C1=__builtin_amdgcn_mfma_f32_32x32x16_bf16(kf[1],qr[0],negm,0,0,0), P0[6],P0[7],P0[8],P0[9],     pw0[2]=PKW(P0,4), pw0[3]=PKW(P0,6), pw0); \
    VRD(1); SBAR(); GAPA(C0=__builtin_amdgcn_mfma_f32_32x32x16_bf16(kf[2],qr[1],C0,0,0,0),   P0[10],P0[11],P0[12],P0[13], pw1[0]=PKW(P0,8), pw1[1]=PKW(P0,10), pw1); \
    VRD(5); SBAR(); GAPA(C1=__builtin_amdgcn_mfma_f32_32x32x16_bf16(kf[3],qr[1],C1,0,0,0),   P0[14],P0[15],P1[0],P1[1],   pw1[2]=PKW(P0,12),pw1[3]=PKW(P0,14), pw1); \
    VRD(2); SBAR(); GAPA(C0=__builtin_amdgcn_mfma_f32_32x32x16_bf16(kf[4],qr[2],C0,0,0,0),   P1[2],P1[3],P1[4],P1[5],     pw2[0]=PKW(P1,0), pw2[1]=PKW(P1,2), pw2); \
    VRD(6); SBAR(); GAPA(C1=__builtin_amdgcn_mfma_f32_32x32x16_bf16(kf[5],qr[2],C1,0,0,0),   P1[6],P1[7],P1[8],P1[9],     pw2[2]=PKW(P1,4), pw2[3]=PKW(P1,6), pw2); \
    VRD(3); SBAR(); GAPA(C0=__builtin_amdgcn_mfma_f32_32x32x16_bf16(kf[6],qr[3],C0,0,0,0),   P1[10],P1[11],P1[12],P1[13], pw3[0]=PKW(P1,8), pw3[1]=PKW(P1,10), pw3); \
    VRD(7); SBAR(); GAPA(C1=__builtin_amdgcn_mfma_f32_32x32x16_bf16(kf[7],qr[3],C1,0,0,0),   P1[14],P1[15],0.f,0.f,       pw3[2]=PKW(P1,12),pw3[3]=PKW(P1,14), pw3); \
    l_reg+=sacc; \
    if(GK){DMA_K((t)+3,sl_cur);} if(GV){DMA_V((t)+1,sl_next);} \
    CMASK(C0,C1,t); \
    { float a=MX3(C0[0],C0[1],C1[0]),b=MX3(C0[2],C0[3],C1[1]); a=MX3(a,C1[2],C1[3]); \
      _Pragma("unroll") for(int r=4;r<16;r+=4){a=MX3(a,C0[r],C0[r+1]);b=MX3(b,C0[r+2],C0[r+3]);a=MX3(a,C1[r],C1[r+1]);b=MX3(b,C1[r+2],C1[r+3]);} \
      float rm=__builtin_fmaxf(a,b); { auto rr=__builtin_amdgcn_permlane32_swap(__float_as_uint(rm),__float_as_uint(rm),false,false); rm=__builtin_fmaxf(__uint_as_float(rr[0]),__uint_as_float(rr[1])); } \
      resc=false; \
      if(__builtin_expect(__any(rm>(float)THRL),0)){ const float dl=__builtin_fmaxf(rm,0.f); mhat+=dl; \
        _Pragma("unroll") for(int r=0;r<16;++r){C0[r]-=dl;C1[r]-=dl;} \
        _Pragma("unroll") for(int r=0;r<16;++r)negm[r]=-mhat; asm volatile("":"+v"(negm)); \
        const float f=__builtin_amdgcn_exp2f(-dl); l_reg*=f; if(hi==0)wsf[r32]=f; resc=true; } } \
    SBAR(); \
    GAPB(o[0]=__builtin_amdgcn_mfma_f32_32x32x16_bf16(PAF(0),VFR(0),o[0],0,0,0), C0,0); \
    GAPB(o[1]=__builtin_amdgcn_mfma_f32_32x32x16_bf16(PAF(0),VFR(4),o[1],0,0,0), C0,4); \
    KRD(GL,0); GAPB(o[0]=__builtin_amdgcn_mfma_f32_32x32x16_bf16(PAF(1),VFR(1),o[0],0,0,0), C0,8); \
    KRD(GL,1); GAPB(o[1]=__builtin_amdgcn_mfma_f32_32x32x16_bf16(PAF(1),VFR(5),o[1],0,0,0), C0,12); \
    KRD(GL,2); GAPB(o[0]=__builtin_amdgcn_mfma_f32_32x32x16_bf16(PAF(2),VFR(2),o[0],0,0,0), C1,0); \
    KRD(GL,3); GAPB(o[1]=__builtin_amdgcn_mfma_f32_32x32x16_bf16(PAF(2),VFR(6),o[1],0,0,0), C1,4); \
    GAPB(o[0]=__builtin_amdgcn_mfma_f32_32x32x16_bf16(PAF(3),VFR(3),o[0],0,0,0), C1,8); \
    GAPB(o[1]=__builtin_amdgcn_mfma_f32_32x32x16_bf16(PAF(3),VFR(7),o[1],0,0,0), C1,12); \
    }while(0)
  int t=1;
  #undef CMASK
  #define CMASK(P0,P1,t) do{}while(0)
  for(;t+5<NT;t+=2){
    STEP(pB0,pB1,pA0,pA1,t,true,true,true);     WAIT_BAR(2); RESC(); ROT();
    STEP(pA0,pA1,pB0,pB1,t+1,true,true,true);   WAIT_BAR(2); RESC(); ROT();
  }
  #undef CMASK
  #define CMASK(P0,P1,t) do{}while(0)
  #define ENDW(tt) do{ if((tt)+3<NT){WAIT_BAR(2);} else if((tt)+2<NT){WAIT_BAR(1);} else {WAIT_BAR(0);} }while(0)
  for(;t+1<NT;t+=2){
    STEP(pB0,pB1,pA0,pA1,t,(t+3<NT),(t+1<NT),(t+1<NT));       ENDW(t);   RESC(); ROT();
    STEP(pA0,pA1,pB0,pB1,t+1,(t+4<NT),(t+2<NT),(t+2<NT));     ENDW(t+1); RESC(); ROT();
  }
  STEP(pB0,pB1,pA0,pA1,NT-1,false,false,false); RESC();
  { float sacc=pB0[0]+pB0[1]; _Pragma("unroll") for(int r=2;r<16;++r)sacc+=pB0[r]; _Pragma("unroll") for(int r=0;r<16;++r)sacc+=pB1[r]; l_reg+=sacc;
    pw0=(u32x4){PKW(pB0,0),PKW(pB0,2),PKW(pB0,4),PKW(pB0,6)};pw1=(u32x4){PKW(pB0,8),PKW(pB0,10),PKW(pB0,12),PKW(pB0,14)};pw2=(u32x4){PKW(pB1,0),PKW(pB1,2),PKW(pB1,4),PKW(pB1,6)};pw3=(u32x4){PKW(pB1,8),PKW(pB1,10),PKW(pB1,12),PKW(pB1,14)};
    SBAR(); pv(o,vb0+sl_cur,PAF(0),PAF(1),PAF(2),PAF(3)); }
  #undef PKW
  #undef PAF
  #undef VFR
  #undef PIN
  #undef MX3
  #undef GAPA
  #undef GAPB
  #undef EX
  #undef VRD
  #undef KRD
  #undef STEP
  #undef ENDW
  {auto rr=__builtin_amdgcn_permlane32_swap(__float_as_uint(l_reg),__float_as_uint(l_reg),false,false);l_reg=__uint_as_float(rr[0])+__uint_as_float(rr[1]);}
  if(hi==0)wsf[32+r32]=l_reg;asm volatile("s_waitcnt lgkmcnt(0)":::"memory");
  float rli[16];
  #pragma unroll
  for(int r=0;r<16;++r)rli[r]=__builtin_amdgcn_rcpf(wsf[32+crow(r,hi)]);
  bf16*Ow=O+(rowbase+q0+wid*QBLK)*OP+h*D;
  { bf16*stg=(bf16*)(shm+LDS_OST)+wid*2048;
    #pragma unroll
    for(int r=0;r<16;++r){const int orow=crow(r,hi);
      #pragma unroll
      for(int d0=0;d0<2;++d0)stg[orow*64+d0*32+r32]=__float2bfloat16(o[d0][r]*rli[r]);}
    asm volatile("s_waitcnt lgkmcnt(0)":::"memory");
    #pragma unroll
    for(int i=0;i<4;++i){const int row=i*8+(lane>>3),ch=lane&7; const u32x4 v=*(const u32x4*)(stg+row*64+ch*8); ATTN_STORE16(Ow+(long)row*OP+ch*8,v);} }
  asm volatile("s_waitcnt lgkmcnt(0)\n\ts_barrier":::"memory");
  #undef DMA_K
  #undef DMA_V
  #undef CMASK
  #undef START
  #undef RESC
  #undef ROT
}
constexpr int ATTN_LDS_BYTES=LDS_BYTES;
struct AttnTensors { const bf16* Q; const bf16* K; const bf16* V; bf16* O; };
struct AttnUnit { int b; int h; int qb; };
struct StaticOrder {
  int vcu, G;
  __device__ __forceinline__ StaticOrder(int grid,int block):vcu((grid%8==0)?(block%8)*(grid/8)+block/8:block),G(grid){}
  __device__ __forceinline__ bool next(int i,AttnUnit&u)const{ const int j=vcu+i*G; if(j>=4*NHEAD*NQB)return false; const int r=j/NQB; u.qb=j%NQB; const int bk=r%8, hl=r/8; u.b=bk/NKVH; u.h=(bk%NKVH)*(NHEAD/NKVH)+hl; return true; }
};
template<int THRL=8> __device__ __forceinline__ void attn_phase(char*lds,const AttnTensors&T,const StaticOrder&S){
  AttnUnit u;
  for(int i=0;S.next(i,u);++i){ attn_unit<THRL>(u.b,u.h,u.qb,T.Q,T.K,T.V,T.O,lds); }
}
#undef SBAR
#undef WAIT_BAR
}
#define GAS __attribute__((address_space(1)))
#define LAS __attribute__((address_space(3)))
typedef unsigned short bf16;
typedef unsigned v4u __attribute__((ext_vector_type(4)));
typedef float f32x4 __attribute__((ext_vector_type(4)));
typedef short bf16x8 __attribute__((ext_vector_type(8)));
typedef GAS unsigned gu32;
typedef GAS unsigned long long gu64;
#define RLX_AGENT __ATOMIC_RELAXED, __HIP_MEMORY_SCOPE_AGENT
#define LDS_WAIT() asm volatile("s_waitcnt lgkmcnt(0)" ::: "memory")
#define VM_WAIT() asm volatile("s_waitcnt vmcnt(0)" ::: "memory")
__device__ __forceinline__ unsigned long long rt() { return __builtin_amdgcn_s_memrealtime(); }
__device__ __forceinline__ unsigned f2bf(float f) { unsigned u = __builtin_bit_cast(unsigned, f); return (u + 0x7fffu + ((u >> 16) & 1u)) >> 16; }
__device__ __forceinline__ unsigned pk2(float lo, float hi) { return f2bf(lo) | (f2bf(hi) << 16); }

#define XB_TMO      128
#define XB_XCNT(j)  (256  + 64 * (j))
#define XB_XSUB(j)  (1280 + 64 * (j))
#define XB_XGEN(j)  (2304 + 64 * (j))
#define XB_TOP      3328
#define XB_TOPGEN   3392
#define XCD_BAR_WORDS 3456
#define XB_SPIN_CAP (1u << 18)

__device__ __forceinline__ unsigned xb_ld(unsigned* p)              { return __hip_atomic_load(p, __ATOMIC_RELAXED, __HIP_MEMORY_SCOPE_AGENT); }
__device__ __forceinline__ unsigned xb_add(unsigned* p, unsigned v) { return __hip_atomic_fetch_add(p, v, __ATOMIC_RELAXED, __HIP_MEMORY_SCOPE_AGENT); }
__device__ __forceinline__ unsigned xb_xcc_id() { return (unsigned)__builtin_amdgcn_s_getreg((3 << 11) | 20) & 0xFu; }
#define XB_SPIN(cond, bar) do { unsigned _sp = 0; while (cond) { __builtin_amdgcn_s_sleep(1); \
    if ((++_sp & 255u) == 0u) { if (xb_ld(&(bar)[XB_TMO])) break; if (_sp > XB_SPIN_CAP) { atomicAdd(&(bar)[XB_TMO], 1u); break; } } } } while (0)

struct XcdBarrier {
    unsigned* bar; unsigned x;
    volatile LAS unsigned* st;
};

__device__ __forceinline__ XcdBarrier xcd_barrier_post(unsigned* bar, volatile LAS unsigned* st) {
    XcdBarrier b; b.bar = bar; b.x = xb_xcc_id(); b.st = st;
    if (threadIdx.x == 0) (void)xb_add(&bar[XB_XCNT(b.x)], 1u);
    return b;
}
__device__ __forceinline__ void xcd_barrier_complete(unsigned* bar, unsigned x, unsigned& nloc, unsigned& nx) {
    const unsigned G = gridDim.x * gridDim.y * gridDim.z;
    unsigned sum, cnt, mine, sp = 0u;
    for (;;) {
        sum = 0u; cnt = 0u; mine = 0u;
#pragma unroll
        for (unsigned j = 0; j < 16; ++j) { const unsigned c = xb_ld(&bar[XB_XCNT(j)]); sum += c; cnt += (c > 0u) ? 1u : 0u; mine = (j == x) ? c : mine; }
        if (sum == G) break;
        __builtin_amdgcn_s_sleep(1);
        if ((++sp & 255u) == 0u) { if (xb_ld(&bar[XB_TMO])) break; if (sp > XB_SPIN_CAP) { atomicAdd(&bar[XB_TMO], 1u); break; } }
    }
    nloc = mine > 0u ? mine : 1u; nx = cnt > 0u ? cnt : 1u;
}

__device__ __forceinline__ void xcd_barrier(const XcdBarrier& b) {
    asm volatile("s_waitcnt vmcnt(0)" ::: "memory");
    __syncthreads();
    if (threadIdx.x == 0) {
        unsigned* bar = b.bar;
        __builtin_amdgcn_s_waitcnt(0);
        unsigned nloc = b.st[0], nx = b.st[1];
        if (nloc == 0u) { xcd_barrier_complete(bar, b.x, nloc, nx); b.st[0] = nloc; b.st[1] = nx; }
        const unsigned old = xb_add(&bar[XB_XSUB(b.x)], 1u);
        const unsigned gen = old / nloc;
        if (old + 1u == (gen + 1u) * nloc) {
            __builtin_amdgcn_fence(__ATOMIC_RELEASE, "agent");
            asm volatile("s_waitcnt vmcnt(0)" ::: "memory");
            const unsigned og = xb_add(&bar[XB_TOP], 1u);
            const unsigned tg = og / nx;
            if (og + 1u == (tg + 1u) * nx) xb_add(&bar[XB_TOPGEN], 1u);
            else XB_SPIN(xb_ld(&bar[XB_TOPGEN]) == tg, bar);
            __builtin_amdgcn_fence(__ATOMIC_ACQUIRE, "agent");
            xb_add(&bar[XB_XGEN(b.x)], 1u);
            asm volatile("s_waitcnt vmcnt(0)" ::: "memory");
        } else {
            XB_SPIN(xb_ld(&bar[XB_XGEN(b.x)]) == gen, bar);
            __builtin_amdgcn_fence(__ATOMIC_ACQUIRE, "agent");
            asm volatile("s_waitcnt vmcnt(0)" ::: "memory");
        }
    }
    __syncthreads();
}

constexpr int NWAVES = 8;
constexpr int DM = 1024, NBATCH = 4, SEQ = 8192, M = NBATCH * SEQ, CTXL = 256, MC = NBATCH * CTXL, MA = M + MC;
constexpr int NIN = 2304, SKV = SEQ + CTXL;
constexpr int DFF = 2816, NEXP = 8, EFF = 3584, NCHUNK = M / 128;
constexpr float EPS = 1e-6f;
constexpr int N_PHASES = 16;
#ifndef MK_PER_PHASE
#define MK_PER_PHASE 0
#endif

constexpr size_t MiB = 1u << 20, QM = 256u * 1024u;
constexpr size_t WS_CTL = 0, CTL_ZERO_BYTES = 1 * MiB;
constexpr size_t WS_MODV = 1 * MiB;
constexpr size_t WS_ROPE = 1 * MiB + QM;
constexpr size_t WS_PERM = 2 * MiB;
constexpr size_t WS_TOKSLOT = 3 * MiB, WS_TOKW = 3 * MiB + QM;
constexpr size_t WS_WIN = 16 * QM, WS_WOUT = 34 * QM, WS_WGU = 42 * QM, WS_WD = 86 * QM, WS_WGIN = 108 * QM, WS_WGOUT = 124 * QM, WS_WSB = 132 * QM, WS_WEGU = 136 * QM, WS_WED = 584 * QM;
constexpr size_t A0 = 808 * QM;
constexpr size_t WS_HX = A0, WS_QKV = A0 + 66 * MiB, WS_Q = A0 + 858 * QM  , WS_KALL = A0 + 986 * QM  , WS_VALL = A0 + 1019 * QM  , WS_AC = A0 + 263 * MiB;
constexpr size_t WS_Y = A0, WS_H2 = A0 + 66 * MiB, WS_HID = A0 + 130 * MiB;
constexpr size_t WS_U = A0 + 130 * MiB, WS_VT = A0 + 194 * MiB, WS_GM = A0 + 258 * MiB, WS_H4 = A0 + 308 * MiB, WS_HIDE = A0, WS_OSL = A0 + 112 * MiB;
constexpr size_t WS_END = A0 + 372 * MiB;
static_assert(WS_WIN + (size_t)NIN * DM * 2 <= WS_WOUT && WS_WOUT + (size_t)DM * DM * 2 <= WS_WGU && WS_WGU + (size_t)2 * DFF * DM * 2 <= WS_WD && WS_WD + (size_t)DM * DFF * 2 <= WS_WGIN &&
              WS_WGIN + (size_t)2048 * DM * 2 <= WS_WGOUT && WS_WGOUT + (size_t)DM * DM * 2 <= WS_WSB && WS_WSB + (size_t)8 * 128 * 128 * 2 <= WS_WEGU && WS_WEGU + (size_t)NEXP * 2 * EFF * DM * 2 <= WS_WED &&
              WS_WED + (size_t)NEXP * DM * EFF * 2 <= A0, "weight map");
static_assert(WS_HX + (size_t)MA * DM * 2 <= WS_QKV && WS_QKV + (size_t)MA * NIN * 2 <= WS_Q && WS_Q + (size_t)M * 512 * 2 <= WS_KALL && WS_KALL + (size_t)NBATCH * SKV * 128 * 2 <= WS_VALL &&
              WS_VALL + (size_t)NBATCH * SKV * 128 * 2 <= WS_AC && WS_AC + (size_t)M * DM * 2 <= WS_END, "layer-0 activation map");
static_assert(WS_HID + (size_t)M * DFF * 2 <= WS_END && WS_H2 + (size_t)M * DM * 2 <= WS_HID && WS_GM + (size_t)M * DM * 2 <= WS_END && WS_HIDE + (size_t)64 * 256 * EFF * 2 <= WS_OSL &&
              WS_OSL + (size_t)264 * 256 * DM * 2 <= WS_H4 && WS_H4 + (size_t)M * DM * 2 <= WS_END, "layer-1 activation map");
constexpr int CW_TMO = 0, CW_CODE = 1, CW_BAR = 4096, CW_CNT = 8192;

constexpr int RING_OFF = 0, RING_BYTES = 131072;
constexpr int LDSCTL_OFF = RING_BYTES, MISC_OFF = LDSCTL_OFF + 320;
constexpr int MOE_OFF = LDSCTL_OFF + 512;
constexpr int IDX_OFF = LDSCTL_OFF + 2048;
constexpr int LDS_BYTES = 147456;
static_assert(MOE_OFF + (32 + 272) * 4 <= IDX_OFF && IDX_OFF + 8 * 256 * 4 <= LDS_BYTES, "LDS map");

struct Frame {
    LAS unsigned char* lds;
    volatile LAS unsigned* MISC;
    gu32* ctl;
    int tid, lane, wave;
    int vcu, G;
};
struct Args { const float* in[35]; float* out; unsigned char* ws; int ph_lo, ph_hi; };

__device__ __forceinline__ float wave_sum(float v) {
#pragma unroll
    for (int o = 1; o < 64; o <<= 1) v += __shfl_xor(v, o);
    return v;
}
__device__ __forceinline__ float bf_lo(unsigned u) { return __uint_as_float(u << 16); }
__device__ __forceinline__ float bf_hi(unsigned u) { return __uint_as_float(u & 0xffff0000u); }
__device__ __forceinline__ float sq4(const f32x4 v) { return (v.x * v.x + v.y * v.y) + (v.z * v.z + v.w * v.w); }
typedef unsigned u32x2 __attribute__((ext_vector_type(2)));
__device__ __forceinline__ void ld_row_f32(const float* row, int lane, f32x4 (&v)[4]) { const GAS f32x4* p = (const GAS f32x4*)row + lane;
#pragma unroll
    for (int j = 0; j < 4; ++j) v[j] = p[64 * j]; }
__device__ __forceinline__ void st_row_f32(float* row, int lane, const f32x4 (&v)[4]) { GAS f32x4* p = (GAS f32x4*)row + lane;
#pragma unroll
    for (int j = 0; j < 4; ++j) p[64 * j] = v[j]; }
__device__ __forceinline__ void ld_row_bf16(const bf16* row, int lane, f32x4 (&v)[4]) { const GAS u32x2* p = (const GAS u32x2*)row + lane;
#pragma unroll
    for (int j = 0; j < 4; ++j) { const u32x2 w = p[64 * j]; v[j] = (f32x4){bf_lo(w.x), bf_hi(w.x), bf_lo(w.y), bf_hi(w.y)}; } }
__device__ __forceinline__ void st_row_bf16(bf16* row, int lane, const f32x4 (&v)[4]) { GAS u32x2* p = (GAS u32x2*)row + lane;
#pragma unroll
    for (int j = 0; j < 4; ++j) { u32x2 w; w.x = pk2(v[j].x, v[j].y); w.y = pk2(v[j].z, v[j].w); p[64 * j] = w; } }
__device__ __forceinline__ void unpack8(const v4u w, float (&f)[8]) { f[0] = bf_lo(w.x); f[1] = bf_hi(w.x); f[2] = bf_lo(w.y); f[3] = bf_hi(w.y); f[4] = bf_lo(w.z); f[5] = bf_hi(w.z); f[6] = bf_lo(w.w); f[7] = bf_hi(w.w); }
__device__ __forceinline__ v4u pack8(const float (&f)[8]) { v4u w; w.x = pk2(f[0], f[1]); w.y = pk2(f[2], f[3]); w.z = pk2(f[4], f[5]); w.w = pk2(f[6], f[7]); return w; }
__device__ __forceinline__ const float* modp(const float* modv, int layer, int j, int chunk) { return modv + ((size_t)(layer * 5 + j) * 6 + chunk) * DM; }

__device__ __forceinline__ void tr_item(const float* W, int K, int N, bf16* WT, int kb, int nb, int drow0, LAS float* scr, int lane) {
    const int k0 = 64 * kb, n0 = 32 * nb;
#pragma unroll 8
    for (int i = 0; i < 32; ++i) { const int kk = 2 * i + (lane >> 5); scr[kk * 33 + (lane & 31)] = W[(size_t)(k0 + kk) * N + n0 + (lane & 31)]; }
    LDS_WAIT(); asm volatile("" ::: "memory");
    const int c = lane & 7;
#pragma unroll
    for (int j = 0; j < 4; ++j) { const int n = (lane >> 3) + 8 * j; const LAS float* s = scr + (8 * c) * 33 + n;
        v4u o; o.x = pk2(s[0 * 33], s[1 * 33]); o.y = pk2(s[2 * 33], s[3 * 33]); o.z = pk2(s[4 * 33], s[5 * 33]); o.w = pk2(s[6 * 33], s[7 * 33]);
        *(GAS v4u*)(WT + (size_t)(drow0 + n) * K + k0 + 8 * c) = o; }
    LDS_WAIT(); asm volatile("" ::: "memory");
}
__device__ __forceinline__ int swiglu_row(int n0) { return 256 * (n0 >> 7) + (n0 & 127); }
__device__ __forceinline__ void sincos_small(float a, float& s, float& c) {
    const float kf = rintf(a * 0.636619772f); const int k = (int)kf;
    float r = fmaf(-kf, 1.5707962513e+00f, a); r = fmaf(-kf, 7.5497894159e-08f, r); r = fmaf(-kf, 5.3903029534e-15f, r);
    const float r2 = r * r;
    const float sp = r + r * r2 * (-1.6666654611e-1f + r2 * (8.3321608736e-3f + r2 * (-1.9515295891e-4f)));
    const float cp = 1.0f - 0.5f * r2 + r2 * r2 * (4.166664568298827e-2f + r2 * (-1.388731625493765e-3f + r2 * 2.443315711809948e-5f));
    const int q = k & 3;
    s = (q == 0) ? sp : (q == 1) ? cp : (q == 2) ? -sp : -cp;
    c = (q == 0) ? cp : (q == 1) ? -sp : (q == 2) ? -cp : sp;
}
__device__ __forceinline__ void p0_mod_item(Frame& F, const float* W, const float* bias, const float* c, const float* cctx, float* modv_layer, int cb) {
    const int col0 = cb * 256; LAS float* red = (LAS float*)F.lds;
    f32x4 acc[5];
#pragma unroll
    for (int j = 0; j < 5; ++j) acc[j] = (f32x4){0.f, 0.f, 0.f, 0.f};
    const int k0 = F.wave * 128;
#pragma unroll 4
    for (int k = k0; k < k0 + 128; ++k) {
        const f32x4 wv = *(const GAS f32x4*)(W + (size_t)k * 6144 + col0 + 4 * F.lane);
#pragma unroll
        for (int j = 0; j < 5; ++j) { const float cj = (j < 4) ? c[j * DM + k] : cctx[k]; const float s = cj / (1.0f + __expf(-cj)); acc[j] += wv * s; }
    }
#pragma unroll
    for (int j = 0; j < 5; ++j) *(LAS f32x4*)(red + ((F.wave * 5 + j) * 256 + 4 * F.lane)) = acc[j];
    __syncthreads();
    for (int o = F.tid; o < 5 * 256; o += NWAVES * 64) { const int j = o >> 8, cc = o & 255; float s = bias[col0 + cc];
#pragma unroll
        for (int w = 0; w < 8; ++w) s += red[(w * 5 + j) * 256 + cc];
        modv_layer[(size_t)j * 6144 + col0 + cc] = s; }
    __syncthreads();
}
__device__ __forceinline__ void p0_prologue(Frame& F, const Args& a) {
    unsigned char* ws = a.ws;
    float* modv = (float*)(ws + WS_MODV);
    for (int it = blockIdx.x; it < 48; it += F.G) { const int layer = it / 24, cb = it % 24;
        p0_mod_item(F, layer ? a.in[18] : a.in[4], layer ? a.in[19] : a.in[5], a.in[1], a.in[3], modv + (size_t)layer * 5 * 6144, cb); }
    const int gt = blockIdx.x * (NWAVES * 64) + F.tid, NGT = F.G * NWAVES * 64;
    { float* tab = (float*)(ws + WS_ROPE);
      for (int i = gt; i < 192 * 16; i += NGT) { const int p = i >> 4, k = i & 15; const float pos = (float)(p < 128 ? p : p - 128);
          const float inv = 1.0f / powf(10000.0f, (float)(2 * k) / 32.0f); float s, c; sincos_small(pos * inv, s, c); tab[2 * i] = c; tab[2 * i + 1] = s; } }
    { const float* wsf = a.in[25]; bf16* wsb = (bf16*)(ws + WS_WSB);
      for (int i = gt; i < 8 * 128 * 128 / 4; i += NGT) { const f32x4 v = *(const GAS f32x4*)(wsf + 4 * (size_t)i); u32x2 w; w.x = pk2(v.x, v.y); w.y = pk2(v.z, v.w); *(GAS u32x2*)(wsb + 4 * (size_t)i) = w; } }
    LAS float* scr = (LAS float*)(F.lds + RING_OFF + F.wave * 16384);
    const int gw = F.vcu * NWAVES + F.wave, NGW = F.G * NWAVES;
    constexpr int I_WIN = 16 * 72, I_WOUT = 16 * 32, I_FG = 16 * 88, I_FD = 44 * 32, I_GIN = 16 * 64, I_GOUT = 16 * 32, I_EG = 16 * 112, I_ED = 56 * 32;
    constexpr int NITEMS = I_WIN + I_WOUT + 2 * I_FG + I_FD + I_GIN + I_GOUT + NEXP * (2 * I_EG + I_ED);
    for (int it = gw; it < NITEMS; it += NGW) {
        int r = it;
        if (r < I_WIN) { tr_item(a.in[8], DM, NIN, (bf16*)(ws + WS_WIN), r / 72, r % 72, 32 * (r % 72), scr, F.lane); continue; } r -= I_WIN;
        if (r < I_WOUT) { tr_item(a.in[12], DM, DM, (bf16*)(ws + WS_WOUT), r / 32, r % 32, 32 * (r % 32), scr, F.lane); continue; } r -= I_WOUT;
        if (r < I_FG) { tr_item(a.in[15], DM, DFF, (bf16*)(ws + WS_WGU), r / 88, r % 88, swiglu_row(32 * (r % 88)), scr, F.lane); continue; } r -= I_FG;
        if (r < I_FG) { tr_item(a.in[16], DM, DFF, (bf16*)(ws + WS_WGU), r / 88, r % 88, swiglu_row(32 * (r % 88)) + 128, scr, F.lane); continue; } r -= I_FG;
        if (r < I_FD) { tr_item(a.in[17], DFF, DM, (bf16*)(ws + WS_WD), r / 32, r % 32, 32 * (r % 32), scr, F.lane); continue; } r -= I_FD;
        if (r < I_GIN) { tr_item(a.in[22], DM, 2048, (bf16*)(ws + WS_WGIN), r / 64, r % 64, 32 * (r % 64), scr, F.lane); continue; } r -= I_GIN;
        if (r < I_GOUT) { tr_item(a.in[27], DM, DM, (bf16*)(ws + WS_WGOUT), r / 32, r % 32, 32 * (r % 32), scr, F.lane); continue; } r -= I_GOUT;
        if (r < NEXP * I_EG) { const int e = r / I_EG, q = r % I_EG; tr_item(a.in[32] + (size_t)e * DM * EFF, DM, EFF, (bf16*)(ws + WS_WEGU), q / 112, q % 112, e * 2 * EFF + swiglu_row(32 * (q % 112)), scr, F.lane); continue; } r -= NEXP * I_EG;
        if (r < NEXP * I_EG) { const int e = r / I_EG, q = r % I_EG; tr_item(a.in[33] + (size_t)e * DM * EFF, DM, EFF, (bf16*)(ws + WS_WEGU), q / 112, q % 112, e * 2 * EFF + swiglu_row(32 * (q % 112)) + 128, scr, F.lane); continue; } r -= NEXP * I_EG;
        { const int e = r / I_ED, q = r % I_ED; tr_item(a.in[34] + (size_t)e * EFF * DM, EFF, DM, (bf16*)(ws + WS_WED), q / 32, q % 32, e * DM + 32 * (q % 32), scr, F.lane); }
    }
}

__device__ __forceinline__ void prenorm_rows16(const float* src, bf16* dst, int lane, const f32x4 (&aa)[4], const f32x4 (&sh)[4], int nrows) {
    for (int i = 0; i < nrows; ++i) {
        f32x4 v[4]; ld_row_f32(src + (size_t)i * DM, lane, v);
        const float ss = wave_sum((sq4(v[0]) + sq4(v[1])) + (sq4(v[2]) + sq4(v[3])));
        const float rstd = rsqrtf(ss * (1.0f / DM) + EPS);
#pragma unroll
        for (int j = 0; j < 4; ++j) v[j] = v[j] * rstd * aa[j] + sh[j];
        st_row_bf16(dst + (size_t)i * DM, lane, v);
    }
}
__device__ __forceinline__ void load_pre_vecs(const float* modv, int layer, int j, int ch_shift, int ch_scale, const float* g, int lane, f32x4 (&aa)[4], f32x4 (&sh)[4]) {
    f32x4 sc[4], gg[4]; ld_row_f32(modp(modv, layer, j, ch_scale), lane, sc); ld_row_f32(g, lane, gg); ld_row_f32(modp(modv, layer, j, ch_shift), lane, sh);
#pragma unroll
    for (int k = 0; k < 4; ++k) aa[k] = gg[k] * (sc[k] + 1.0f);
}
__device__ __forceinline__ void p1_prenorm(Frame& F, const Args& a) {
    const float* modv = (const float*)(a.ws + WS_MODV); bf16* HX = (bf16*)(a.ws + WS_HX);
    const int gw = F.vcu * NWAVES + F.wave, NGW = F.G * NWAVES;
    for (int blk = gw; blk < M / 16; blk += NGW) { const int m0 = blk * 16, b = m0 / SEQ;
        f32x4 aa[4], sh[4]; load_pre_vecs(modv, 0, b, 0, 1, a.in[6], F.lane, aa, sh);
        prenorm_rows16(a.in[0] + (size_t)m0 * DM, HX + (size_t)m0 * DM, F.lane, aa, sh, 16); }
    for (int blk = gw; blk < MC / 16; blk += NGW) { const int m0 = blk * 16;
        f32x4 aa[4], sh[4]; load_pre_vecs(modv, 0, 4, 0, 1, a.in[6], F.lane, aa, sh);
        prenorm_rows16(a.in[2] + (size_t)m0 * DM, HX + (size_t)(M + m0) * DM, F.lane, aa, sh, 16); }
}

constexpr float ATT_C2 = 0.125f * 1.4426950408889634f;
__device__ __forceinline__ void norm_rope8(float (&x)[8], const float (&g)[8], int lane, bool do_rope, const float* tab_lo  , float outscale) {
    float ss = 0.f;
#pragma unroll
    for (int e = 0; e < 8; ++e) ss += x[e] * x[e];
    ss += __shfl_xor(ss, 1); ss += __shfl_xor(ss, 2); ss += __shfl_xor(ss, 4);
    const float rstd = rsqrtf(ss * (1.0f / 64.0f) + EPS);
#pragma unroll
    for (int e = 0; e < 8; ++e) x[e] = x[e] * rstd * g[e];
    float p[8];
#pragma unroll
    for (int e = 0; e < 8; ++e) p[e] = __shfl_xor(x[e], 4);
    if (do_rope) {
        const bool upper = (lane & 4) != 0;
#pragma unroll
        for (int e = 0; e < 8; ++e) { const float cs = tab_lo[2 * e], sn = tab_lo[2 * e + 1]; x[e] = upper ? (x[e] * cs + p[e] * sn) : (x[e] * cs - p[e] * sn); }
    }
#pragma unroll
    for (int e = 0; e < 8; ++e) x[e] *= outscale;
}
__device__ __forceinline__ void p3_qkv_post(Frame& F, const Args& a) {
    unsigned char* ws = a.ws;
    const bf16* QKV = (const bf16*)(ws + WS_QKV); bf16* Q = (bf16*)(ws + WS_Q); bf16* KALL = (bf16*)(ws + WS_KALL); bf16* VALL = (bf16*)(ws + WS_VALL); bf16* AC = (bf16*)(ws + WS_AC);
    const float* tab = (const float*)(ws + WS_ROPE); const float* gq = a.in[9]; const float* gk = a.in[10]; const float* wconv = a.in[11];
    const int lane = F.lane, gw = F.vcu * NWAVES + F.wave, NGW = F.G * NWAVES;
    const int d0 = 8 * (lane & 7);
    float gq8[8], gk8[8], w0[8], w1[8], w2[8];
#pragma unroll
    for (int e = 0; e < 8; ++e) { gq8[e] = gq[d0 + e]; gk8[e] = gk[d0 + e]; w0[e] = wconv[8 * lane + e]; w1[e] = wconv[512 + 8 * lane + e]; w2[e] = wconv[1024 + 8 * lane + e]; }
    const int pi0 = 8 * (lane & 3);
    for (int m = gw; m < MA; m += NGW) {
        const bf16* row = QKV + (size_t)m * NIN;
        if (m < M) {
            const int b = m / SEQ, t = m % SEQ, gr = t >> 6, gc = t & 63;
            const float* tl = tab + 2 * (size_t)((pi0 < 16 ? gr : 128 + gc) * 16 + (pi0 & 15));
            { float x[8]; unpack8(*(const GAS v4u*)(row + 8 * lane), x); norm_rope8(x, gq8, lane, true, tl, ATT_C2); *(GAS v4u*)(Q + (size_t)m * 512 + 8 * lane) = pack8(x); }
            { float x[8]; v4u kw = (v4u){0u, 0u, 0u, 0u}; if (lane < 16) kw = *(const GAS v4u*)(row + 512 + 8 * lane); unpack8(kw, x); norm_rope8(x, gk8, lane, true, tl, 1.0f);
              const size_t kvrow = (size_t)b * SKV + CTXL + t;
              if (lane < 16) { *(GAS v4u*)(KALL + kvrow * 128 + 8 * lane) = pack8(x); *(GAS v4u*)(VALL + kvrow * 128 + 8 * lane) = *(const GAS v4u*)(row + 640 + 8 * lane); } }
            { float Bg[8], c0[8], h0[8], z[8], zp[8], zn[8];
              unpack8(*(const GAS v4u*)(row + 768 + 8 * lane), Bg); unpack8(*(const GAS v4u*)(row + 1280 + 8 * lane), c0); unpack8(*(const GAS v4u*)(row + 1792 + 8 * lane), h0);
#pragma unroll
              for (int e = 0; e < 8; ++e) { z[e] = c0[e] * h0[e]; zp[e] = 0.f; zn[e] = 0.f; }
              if (t > 0) { float c1[8], h1[8]; unpack8(*(const GAS v4u*)(row - NIN + 1280 + 8 * lane), c1); unpack8(*(const GAS v4u*)(row - NIN + 1792 + 8 * lane), h1);
#pragma unroll
                  for (int e = 0; e < 8; ++e) zp[e] = c1[e] * h1[e]; }
              if (t < SEQ - 1) { float c1[8], h1[8]; unpack8(*(const GAS v4u*)(row + NIN + 1280 + 8 * lane), c1); unpack8(*(const GAS v4u*)(row + NIN + 1792 + 8 * lane), h1);
#pragma unroll
                  for (int e = 0; e < 8; ++e) zn[e] = c1[e] * h1[e]; }
              float o[8];
#pragma unroll
              for (int e = 0; e < 8; ++e) o[e] = Bg[e] * (w0[e] * zp[e] + w1[e] * z[e] + w2[e] * zn[e]);
              *(GAS v4u*)(AC + (size_t)m * DM + 512 + 8 * lane) = pack8(o); }
        } else {
            const int j = m - M, b = j / CTXL, jj = j % CTXL;
            float x[8]; v4u kw = (v4u){0u, 0u, 0u, 0u}; if (lane < 16) kw = *(const GAS v4u*)(row + 512 + 8 * lane); unpack8(kw, x); norm_rope8(x, gk8, lane, false, tab, 1.0f);
            const size_t kvrow = (size_t)b * SKV + jj;
            if (lane < 16) { *(GAS v4u*)(KALL + kvrow * 128 + 8 * lane) = pack8(x); *(GAS v4u*)(VALL + kvrow * 128 + 8 * lane) = *(const GAS v4u*)(row + 640 + 8 * lane); }
        }
    }
}

template <bool ROUTE>
__device__ __forceinline__ void rows_update(Frame& F, const Args& a, const float* xin, const bf16* Y, int layer, int ch_gate, const float* gpost, int nlayer, int ch_shift, int ch_scale, const float* gpre, bf16* H) {
    const float* modv = (const float*)(a.ws + WS_MODV); float* xout = a.out;
    const int lane = F.lane, gw = F.vcu * NWAVES + F.wave, NGW = F.G * NWAVES;
    LAS float* wrl = (LAS float*)(F.lds + RING_OFF);
    if (ROUTE) { const float* wr = a.in[30]; for (int i = F.tid; i < DM * NEXP / 4; i += NWAVES * 64) *(LAS f32x4*)(wrl + 4 * i) = *(const GAS f32x4*)(wr + 4 * i); __syncthreads(); }
    for (int blk = gw; blk < M / 16; blk += NGW) { const int m0 = blk * 16, b = m0 / SEQ;
        f32x4 gg[4], aa[4], sh[4];
        { f32x4 gt[4], gp[4]; ld_row_f32(modp(modv, layer, b, ch_gate), lane, gt); ld_row_f32(gpost, lane, gp);
#pragma unroll
          for (int k = 0; k < 4; ++k) gg[k] = gt[k] * gp[k]; }
        load_pre_vecs(modv, nlayer, b, ch_shift, ch_scale, gpre, lane, aa, sh);
        int me0 = 0, me1 = 0; float mw0 = 0.f, mw1 = 0.f;
        for (int i = 0; i < 16; ++i) { const size_t m = (size_t)(m0 + i);
            f32x4 x[4], y[4]; ld_row_f32(xin + m * DM, lane, x); ld_row_bf16(Y + m * DM, lane, y);
            const float ssy = wave_sum((sq4(y[0]) + sq4(y[1])) + (sq4(y[2]) + sq4(y[3])));
            const float ry = rsqrtf(ssy * (1.0f / DM) + EPS);
#pragma unroll
            for (int j = 0; j < 4; ++j) x[j] = x[j] + gg[j] * (y[j] * ry);
            st_row_f32(xout + m * DM, lane, x);
            const float ssx = wave_sum((sq4(x[0]) + sq4(x[1])) + (sq4(x[2]) + sq4(x[3])));
            const float rx = rsqrtf(ssx * (1.0f / DM) + EPS);
#pragma unroll
            for (int j = 0; j < 4; ++j) x[j] = x[j] * rx * aa[j] + sh[j];
            st_row_bf16(H + m * DM, lane, x);
            if (ROUTE) {
                float lg[8];
#pragma unroll
                for (int e = 0; e < 8; ++e) lg[e] = 0.f;
#pragma unroll
                for (int j = 0; j < 4; ++j)
#pragma unroll
                    for (int q = 0; q < 4; ++q) { const LAS float* wp = wrl + (256 * j + 4 * lane + q) * 8; const f32x4 wa = *(const LAS f32x4*)wp, wb = *(const LAS f32x4*)(wp + 4); const float hv = x[j][q];
                        lg[0] += hv * wa.x; lg[1] += hv * wa.y; lg[2] += hv * wa.z; lg[3] += hv * wa.w; lg[4] += hv * wb.x; lg[5] += hv * wb.y; lg[6] += hv * wb.z; lg[7] += hv * wb.w; }
                const float* br = a.in[31];
#pragma unroll
                for (int e = 0; e < 8; ++e) lg[e] = wave_sum(lg[e]) + br[e];
                int e0 = 0; float l0 = lg[0];
#pragma unroll
                for (int e = 1; e < 8; ++e) if (lg[e] > l0) { l0 = lg[e]; e0 = e; }
                int e1 = -1; float l1 = -INFINITY;
#pragma unroll
                for (int e = 0; e < 8; ++e) if (e != e0 && lg[e] > l1) { l1 = lg[e]; e1 = e; }
                const float w0 = 1.0f / (1.0f + __expf(l1 - l0));
                if (lane == i) { me0 = e0; me1 = e1; mw0 = w0; mw1 = 1.0f - w0; }
            }
        }
        if (ROUTE) {
            gu32* cnt = F.ctl + CW_CNT; int* perm = (int*)(a.ws + WS_PERM); int* tokslot = (int*)(a.ws + WS_TOKSLOT); float* tokw = (float*)(a.ws + WS_TOKW);
#pragma unroll 1
            for (int e = 0; e < NEXP; ++e) {
                const bool has = (lane < 16) && (me0 == e || me1 == e);
                const unsigned long long mask = __ballot(has); const int n = __popcll(mask);
                if (n) { unsigned base = 0u; if (lane == 0) base = __hip_atomic_fetch_add(cnt + 64 * e, (unsigned)n, RLX_AGENT); base = (unsigned)__shfl((int)base, 0);
                    if (has) { const int rank = (int)base + __popcll(mask & ((1ull << lane) - 1ull)); const int k = (me0 == e) ? 0 : 1; const int tok = m0 + lane;
                        perm[(size_t)e * M + rank] = tok; tokslot[2 * tok + k] = e * 32768 + rank; tokw[2 * tok + k] = k ? mw1 : mw0; } }
            }
        }
    }
    if (ROUTE) __syncthreads();
}

__device__ __forceinline__ void p11_spatial(Frame& F, const Args& a) {
    typedef float f32x16 __attribute__((ext_vector_type(16))); typedef float f32x2v __attribute__((ext_vector_type(2)));
    unsigned char* ws = a.ws;
    const bf16* VT = (const bf16*)(ws + WS_VT); const bf16* U = (const bf16*)(ws + WS_U); const bf16* WSB = (const bf16*)(ws + WS_WSB); bf16* GM = (bf16*)(ws + WS_GM);
    const float* gv = a.in[23]; const float* bv = a.in[24]; const float* bs = a.in[26];
    const int lane = F.lane, g = F.wave, l32 = lane & 31, hi = lane >> 5;
    LAS f32x2v* part = (LAS f32x2v*)(F.lds + RING_OFF);
    LAS f32x2v* stat = (LAS f32x2v*)(F.lds + RING_OFF + 8192);
    for (int ch = F.vcu; ch < NCHUNK; ch += F.G) {
        const bf16* vt = VT + (size_t)ch * DM * 128;
        { float s[8], q[8];
#pragma unroll
          for (int e = 0; e < 8; ++e) { s[e] = 0.f; q[e] = 0.f; }
#pragma unroll 4
          for (int it = 0; it < 32; ++it) { const int c = 128 * g + 4 * it + (lane >> 4); float v[8]; unpack8(*(const GAS v4u*)(vt + (size_t)c * 128 + 8 * (lane & 15)), v);
#pragma unroll
              for (int e = 0; e < 8; ++e) { s[e] += v[e]; q[e] += v[e] * v[e]; } }
#pragma unroll
          for (int e = 0; e < 8; ++e) { s[e] += __shfl_xor(s[e], 16); s[e] += __shfl_xor(s[e], 32); q[e] += __shfl_xor(q[e], 16); q[e] += __shfl_xor(q[e], 32); }
          if (lane < 16) {
#pragma unroll
              for (int e = 0; e < 8; ++e) part[g * 128 + 8 * lane + e] = (f32x2v){s[e], q[e]}; } }
        __syncthreads();
        if (F.tid < 128) { float s = 0.f, q = 0.f;
#pragma unroll
            for (int w = 0; w < 8; ++w) { const f32x2v p = part[w * 128 + F.tid]; s += p.x; q += p.y; }
            const float mu = s * (1.0f / DM); const float var = fmaxf(q * (1.0f / DM) - mu * mu, 0.f); stat[F.tid] = (f32x2v){mu, rsqrtf(var + EPS)}; }
        __syncthreads();
        const bf16* wg = WSB + (size_t)g * 128 * 128;
#pragma unroll 1
        for (int nt = 0; nt < 4; ++nt) {
            f32x16 acc[4];
#pragma unroll
            for (int mt = 0; mt < 4; ++mt)
#pragma unroll
                for (int r = 0; r < 16; ++r) acc[mt][r] = 0.f;
            const int c = 128 * g + 32 * nt + l32; const float gvc = gv[c], bvc = bv[c];
            const bf16* vc = vt + (size_t)c * 128 + 8 * hi; const bf16* wl = wg + (size_t)l32 * 128 + 8 * hi;
            bf16x8 afn[4]; v4u vn;
#pragma unroll
            for (int mt = 0; mt < 4; ++mt) afn[mt] = *(const GAS bf16x8*)(wl + (size_t)mt * 32 * 128);
            vn = *(const GAS v4u*)vc;
#pragma unroll 1
            for (int ks = 0; ks < 8; ++ks) {
                bf16x8 af[4]; const v4u vr = vn;
#pragma unroll
                for (int mt = 0; mt < 4; ++mt) af[mt] = afn[mt];
                if (ks < 7) {
#pragma unroll
                    for (int mt = 0; mt < 4; ++mt) afn[mt] = *(const GAS bf16x8*)(wl + (size_t)mt * 32 * 128 + 16 * (ks + 1));
                    vn = *(const GAS v4u*)(vc + 16 * (ks + 1)); }
                const int q0 = 16 * ks + 8 * hi;
                float v[8]; unpack8(vr, v);
#pragma unroll
                for (int e = 0; e < 8; ++e) { const f32x2v st = stat[q0 + e]; v[e] = (v[e] - st.x) * st.y * gvc + bvc; }
                const v4u pk = pack8(v); const bf16x8 bfr = __builtin_bit_cast(bf16x8, pk);
#pragma unroll
                for (int mt = 0; mt < 4; ++mt) acc[mt] = __builtin_amdgcn_mfma_f32_32x32x16_bf16(bfr, af[mt], acc[mt], 0, 0, 0);
            }
            u32x2 uu[4][4]; float bsv[4];
#pragma unroll
            for (int mt = 0; mt < 4; ++mt) { const int p = 32 * mt + l32; bsv[mt] = bs[g * 128 + p]; const bf16* up = U + ((size_t)ch * 128 + p) * DM + 128 * g + 32 * nt + 4 * hi;
#pragma unroll
                for (int rr = 0; rr < 4; ++rr) uu[mt][rr] = *(const GAS u32x2*)(up + 8 * rr); }
#pragma unroll
            for (int mt = 0; mt < 4; ++mt) { const int p = 32 * mt + l32; bf16* gp = GM + ((size_t)ch * 128 + p) * DM + 128 * g + 32 * nt + 4 * hi;
#pragma unroll
                for (int rr = 0; rr < 4; ++rr) { const u32x2 w = uu[mt][rr]; u32x2 o;
                    o.x = pk2(bf_lo(w.x) * (acc[mt][4 * rr + 0] + bsv[mt]), bf_hi(w.x) * (acc[mt][4 * rr + 1] + bsv[mt]));
                    o.y = pk2(bf_lo(w.y) * (acc[mt][4 * rr + 2] + bsv[mt]), bf_hi(w.y) * (acc[mt][4 * rr + 3] + bsv[mt]));
                    *(GAS u32x2*)(gp + 8 * rr) = o; } }
        }
        __syncthreads();
    }
}

__device__ __forceinline__ void moe_tables(Frame& F) {
    LAS int* mt = (LAS int*)(F.lds + MOE_OFF);
    if (F.tid < NEXP) mt[F.tid] = (int)__hip_atomic_load(F.ctl + CW_CNT + 64 * F.tid, RLX_AGENT);
    __syncthreads();
    if (F.tid == 0) { int off = 0;
        for (int e = 0; e < NEXP; ++e) { mt[8 + e] = off; const int n = (mt[e] + 255) >> 8; for (int t = 0; t < n && off + t < 272; ++t) mt[32 + off + t] = e; off += n; }
        mt[16] = off; mt[24] = off < 272 ? off : 272; }
    __syncthreads();
}
__device__ __forceinline__ void p15_final(Frame& F, const Args& a) {
    const float* modv = (const float*)(a.ws + WS_MODV); const bf16* OSL = (const bf16*)(a.ws + WS_OSL); const int* tokslot = (const int*)(a.ws + WS_TOKSLOT); const float* tokw = (const float*)(a.ws + WS_TOKW);
    const LAS int* mt = (const LAS int*)(F.lds + MOE_OFF);
    const int lane = F.lane, gw = F.vcu * NWAVES + F.wave, NGW = F.G * NWAVES;
    for (int blk = gw; blk < M / 16; blk += NGW) { const int m0 = blk * 16, b = m0 / SEQ;
        f32x4 gg[4];
        { f32x4 gt[4], gp[4]; ld_row_f32(modp(modv, 1, b, 5), lane, gt); ld_row_f32(a.in[29], lane, gp);
#pragma unroll
          for (int k = 0; k < 4; ++k) gg[k] = gt[k] * gp[k]; }
        for (int i = 0; i < 16; ++i) { const size_t m = (size_t)(m0 + i);
            const int s0 = tokslot[2 * m], s1 = tokslot[2 * m + 1]; const float w0 = tokw[2 * m], w1 = tokw[2 * m + 1];
            const size_t r0 = (size_t)mt[8 + (s0 >> 15)] * 256 + (s0 & 32767), r1 = (size_t)mt[8 + (s1 >> 15)] * 256 + (s1 & 32767);
            f32x4 x[4], f0[4], f1[4]; ld_row_f32(a.out + m * DM, lane, x); ld_row_bf16(OSL + r0 * DM, lane, f0); ld_row_bf16(OSL + r1 * DM, lane, f1);
#pragma unroll
            for (int j = 0; j < 4; ++j) f0[j] = f0[j] * w0 + f1[j] * w1;
            const float ss = wave_sum((sq4(f0[0]) + sq4(f0[1])) + (sq4(f0[2]) + sq4(f0[3])));
            const float rf = rsqrtf(ss * (1.0f / DM) + EPS);
#pragma unroll
            for (int j = 0; j < 4; ++j) x[j] = x[j] + gg[j] * (f0[j] * rf);
            st_row_f32(a.out + m * DM, lane, x);
        }
    }
}

__global__ void __launch_bounds__(NWAVES * 64, 2) mk_fwd(Args args) {
    extern __shared__ __attribute__((aligned(16))) unsigned char lds[];
    Frame F;
    F.lds = (LAS unsigned char*)lds;
    F.MISC = (volatile LAS unsigned*)(F.lds + MISC_OFF);
    F.tid = threadIdx.x; F.lane = F.tid & 63; F.wave = __builtin_amdgcn_readfirstlane(F.tid >> 6);
    F.G = gridDim.x; { const int bx = blockIdx.x; F.vcu = (F.G % 8 == 0) ? (bx % 8) * (F.G / 8) + bx / 8 : bx; }
    unsigned char* ws = args.ws;
    F.ctl = (gu32*)(ws + WS_CTL);
    for (int u = F.tid; u < (LDS_BYTES - LDSCTL_OFF) / 4; u += NWAVES * 64) ((LAS unsigned*)(F.lds + LDSCTL_OFF))[u] = 0u;
    __syncthreads();
    const int lo = args.ph_lo, hi = args.ph_hi;
    XcdBarrier bar; bar.bar = (unsigned*)(F.ctl + CW_BAR); bar.x = 0; bar.st = nullptr;
    if (hi - lo > 1 || (lo <= 14 && 14 < hi)) bar = xcd_barrier_post((unsigned*)(F.ctl + CW_BAR), F.MISC + 8);
#ifndef PH_MASK
#define PH_MASK 0xFFFF
#endif
#define IN(k) ((((PH_MASK) >> (k)) & 1) && lo <= (k) && (k) < hi)
#define BOTH(k) (IN(k) && IN((k) + 1))
#define GRID_BAR() xcd_barrier(bar)
    PG8_LAS unsigned char* ring = F.lds + RING_OFF;
    const int cb = (int)blockIdx.x;
#ifndef REPEAT_PHASE
#define REPEAT_PHASE (-1)
#endif
#define NREP(k) ((REPEAT_PHASE == (k)) ? 2 : 1)

    if (IN(0)) for (int rep = 0; rep < NREP(0); ++rep) { p0_prologue(F, args); if (BOTH(0) || rep + 1 < NREP(0)) GRID_BAR(); }
    if (IN(1)) for (int rep = 0; rep < NREP(1); ++rep) { p1_prenorm(F, args); if (BOTH(1) || rep + 1 < NREP(1)) GRID_BAR(); }
    if (IN(2)) for (int rep = 0; rep < NREP(2); ++rep) {
        pg8::Gemm g{(const pg8::bf16_t*)(ws + WS_HX), (const pg8::bf16_t*)(ws + WS_WIN), MA, NIN, DM}; pg8::InProjOrder S{M / 256, NIN / 256, MC / 256, 2, F.G, cb};
        pg8::EpiBf16<0> E{(pg8::bf16_t*)(ws + WS_QKV), NIN, 0, 0};
        pg8::gemm_phase<pg8::EpiBf16<0>, pg8::InProjOrder, true, false, false>(ring, g, S, E, nullptr);
        if (BOTH(2) || rep + 1 < NREP(2)) GRID_BAR(); }
    if (IN(3)) for (int rep = 0; rep < NREP(3); ++rep) { p3_qkv_post(F, args); if (BOTH(3) || rep + 1 < NREP(3)) GRID_BAR(); }
    if (IN(4)) for (int rep = 0; rep < NREP(4); ++rep) {
        const attn_body::AttnTensors AT{(const attn_body::bf16*)(ws + WS_Q), (const attn_body::bf16*)(ws + WS_KALL), (const attn_body::bf16*)(ws + WS_VALL), (attn_body::bf16*)(ws + WS_AC)};
        const attn_body::StaticOrder S((int)F.G, cb);
        attn_body::attn_phase<8>((char*)lds + RING_OFF, AT, S);
        if (BOTH(4) || rep + 1 < NREP(4)) GRID_BAR(); }
    if (IN(5)) for (int rep = 0; rep < NREP(5); ++rep) {
        pg8::Gemm g{(const pg8::bf16_t*)(ws + WS_AC), (const pg8::bf16_t*)(ws + WS_WOUT), M, DM, DM}; pg8::GridOrder S{M / 256, DM / 256, F.G, cb};
        pg8::EpiBf16<0> E{(pg8::bf16_t*)(ws + WS_Y), DM, 0, 0};
        pg8::gemm_phase<pg8::EpiBf16<0>, pg8::GridOrder, true, false, false>(ring, g, S, E, nullptr);
        if (BOTH(5) || rep + 1 < NREP(5)) GRID_BAR(); }
    if (IN(6)) for (int rep = 0; rep < NREP(6); ++rep) { rows_update<false>(F, args, args.in[0], (const bf16*)(ws + WS_Y), 0, 2, args.in[7], 0, 3, 4, args.in[13], (bf16*)(ws + WS_H2)); if (BOTH(6) || rep + 1 < NREP(6)) GRID_BAR(); }
    if (IN(7)) for (int rep = 0; rep < NREP(7); ++rep) {
        pg8::Gemm g{(const pg8::bf16_t*)(ws + WS_H2), (const pg8::bf16_t*)(ws + WS_WGU), M, 2 * DFF, DM}; pg8::GridOrder S{M / 256, 2 * DFF / 256, F.G, cb};
        pg8::EpiSwiGLU E{(pg8::bf16_t*)(ws + WS_HID), DFF, 0, 0};
        pg8::gemm_phase<pg8::EpiSwiGLU, pg8::GridOrder, true, false, false>(ring, g, S, E, nullptr);
        if (BOTH(7) || rep + 1 < NREP(7)) GRID_BAR(); }
    if (IN(8)) for (int rep = 0; rep < NREP(8); ++rep) {
        pg8::Gemm g{(const pg8::bf16_t*)(ws + WS_HID), (const pg8::bf16_t*)(ws + WS_WD), M, DM, DFF}; pg8::GridOrder S{M / 256, DM / 256, F.G, cb};
        pg8::EpiBf16<0> E{(pg8::bf16_t*)(ws + WS_Y), DM, 0, 0};
        pg8::gemm_phase<pg8::EpiBf16<0>, pg8::GridOrder, true, false, false>(ring, g, S, E, nullptr);
        if (BOTH(8) || rep + 1 < NREP(8)) GRID_BAR(); }
    if (IN(9)) for (int rep = 0; rep < NREP(9); ++rep) { rows_update<false>(F, args, args.out, (const bf16*)(ws + WS_Y), 0, 5, args.in[14], 1, 0, 1, args.in[20], (bf16*)(ws + WS_H2)); if (BOTH(9) || rep + 1 < NREP(9)) GRID_BAR(); }
    if (IN(10)) for (int rep = 0; rep < NREP(10); ++rep) {
        { pg8::Gemm g{(const pg8::bf16_t*)(ws + WS_H2), (const pg8::bf16_t*)(ws + WS_WGIN), M, DM, DM}; pg8::GridOrder S{M / 256, DM / 256, F.G, cb};
          pg8::EpiBf16<1> E{(pg8::bf16_t*)(ws + WS_U), DM, 0, 0};
          pg8::gemm_phase<pg8::EpiBf16<1>, pg8::GridOrder, true, false, false>(ring, g, S, E, nullptr); }
        { pg8::Gemm g{(const pg8::bf16_t*)(ws + WS_H2), (const pg8::bf16_t*)(ws + WS_WGIN) + (size_t)DM * DM, M, DM, DM}; pg8::GridOrder S{M / 256, DM / 256, F.G, cb};
          pg8::EpiGeluT E{(pg8::bf16_t*)(ws + WS_VT), DM};
          pg8::gemm_phase<pg8::EpiGeluT, pg8::GridOrder, true, true, false>(ring, g, S, E, nullptr); }
        if (BOTH(10) || rep + 1 < NREP(10)) GRID_BAR(); }
    if (IN(11)) for (int rep = 0; rep < NREP(11); ++rep) { p11_spatial(F, args); if (BOTH(11) || rep + 1 < NREP(11)) GRID_BAR(); }
    if (IN(12)) for (int rep = 0; rep < NREP(12); ++rep) {
        pg8::Gemm g{(const pg8::bf16_t*)(ws + WS_GM), (const pg8::bf16_t*)(ws + WS_WGOUT), M, DM, DM}; pg8::GridOrder S{M / 256, DM / 256, F.G, cb};
        pg8::EpiBf16<0> E{(pg8::bf16_t*)(ws + WS_Y), DM, 0, 0};
        pg8::gemm_phase<pg8::EpiBf16<0>, pg8::GridOrder, true, false, false>(ring, g, S, E, nullptr);
        if (BOTH(12) || rep + 1 < NREP(12)) GRID_BAR(); }
    if (IN(13)) for (int rep = 0; rep < NREP(13); ++rep) { rows_update<true>(F, args, args.out, (const bf16*)(ws + WS_Y), 1, 2, args.in[21], 1, 3, 4, args.in[28], (bf16*)(ws + WS_H4)); if (BOTH(13) || rep + 1 < NREP(13)) GRID_BAR(); }
    if (IN(14)) {
        moe_tables(F);
        const PG8_LAS int* mt = (const PG8_LAS int*)(F.lds + MOE_OFF); PG8_LAS int* idx = (PG8_LAS int*)(F.lds + IDX_OFF);
        const int T = mt[24]; const int* perm = (const int*)(ws + WS_PERM);
#pragma unroll 1
        for (int rep = 0; rep < NREP(14); ++rep)
#pragma unroll 1
        for (int tile0 = 0; tile0 < T; tile0 += 64) { const int nM = (T - tile0) < 64 ? (T - tile0) : 64;
            { pg8::MoeOrder S{nM, 2 * EFF / 256, F.G, cb, tile0, mt + 32};
              for (int i = 0; i < 8; ++i) { pg8::Unit u; if (!S.next(i, u)) break;
                  if (F.tid < 256) { const int tl = tile0 + u.pm, e = mt[32 + tl], cn = mt[e]; int rank = (tl - mt[8 + e]) * 256 + F.tid; if (rank >= cn) rank = cn - 1; idx[i * 256 + F.tid] = perm[(size_t)e * M + rank]; } }
              __syncthreads();
              pg8::Gemm g{(const pg8::bf16_t*)(ws + WS_H4), (const pg8::bf16_t*)(ws + WS_WEGU), M, 2 * EFF, DM};
              pg8::EpiSwiGLU E{(pg8::bf16_t*)(ws + WS_HIDE), EFF, 2 * EFF / 256, 0};
              pg8::gemm_phase<pg8::EpiSwiGLU, pg8::MoeOrder, true, false, true>(ring, g, S, E, idx); }
            GRID_BAR();
            { pg8::MoeOrder S{nM, DM / 256, F.G, cb, tile0, mt + 32};
              pg8::Gemm g{(const pg8::bf16_t*)(ws + WS_HIDE), (const pg8::bf16_t*)(ws + WS_WED), 64 * 256, DM, EFF};
              pg8::EpiBf16<0> E{(pg8::bf16_t*)(ws + WS_OSL), DM, DM / 256, tile0 * 256};
              pg8::gemm_phase<pg8::EpiBf16<0>, pg8::MoeOrder, true, false, false>(ring, g, S, E, nullptr); }
            GRID_BAR();
        }
    }
    if (IN(15)) { if (!IN(14)) moe_tables(F); p15_final(F, args); }
#undef IN
#undef BOTH
#undef GRID_BAR
}

extern "C" void kernel_launch(void* const* d_in, const int* in_sizes, int n_in, void* d_out, int out_size, void* d_ws, size_t ws_size, hipStream_t stream) {
    static int grid = 0;
    if (grid == 0) {
        if (n_in != 35 || in_sizes[0] != M * DM || out_size != M * DM || ws_size < WS_END) { fprintf(stderr, "kernel_launch: unexpected shapes / workspace (%d inputs, ws %zu, need %zu); nothing launched\n", n_in, ws_size, (size_t)WS_END); grid = -1; return; }
        int dev = 0, cus = 0;
        if (hipGetDevice(&dev) != hipSuccess || hipDeviceGetAttribute(&cus, hipDeviceAttributeMultiprocessorCount, dev) != hipSuccess) { grid = -1; return; }
        if (hipFuncSetAttribute((const void*)mk_fwd, hipFuncAttributeMaxDynamicSharedMemorySize, LDS_BYTES) != hipSuccess) { fprintf(stderr, "kernel_launch: hipFuncSetAttribute failed\n"); grid = -1; return; }
        int per_cu = 0;
        if (hipOccupancyMaxActiveBlocksPerMultiprocessor(&per_cu, (const void*)mk_fwd, NWAVES * 64, LDS_BYTES) != hipSuccess || per_cu < 1) fprintf(stderr, "kernel_launch: note: occupancy query reports %d workgroups per CU\n", per_cu);
        (void)hipGetLastError();
        grid = cus;
    }
    if (grid < 0) return;
    if (hipMemsetAsync((char*)d_ws + WS_CTL, 0, CTL_ZERO_BYTES, stream) != hipSuccess) return;
    Args a{};
    for (int i = 0; i < 35; ++i) a.in[i] = (const float*)d_in[i];
    a.out = (float*)d_out; a.ws = (unsigned char*)d_ws;
#if MK_PER_PHASE
    for (int p = 0; p < N_PHASES; ++p) { a.ph_lo = p; a.ph_hi = p + 1; hipLaunchKernelGGL(mk_fwd, dim3(grid), dim3(NWAVES * 64), LDS_BYTES, stream, a); }
#else
    a.ph_lo = 0; a.ph_hi = N_PHASES;
    hipLaunchKernelGGL(mk_fwd, dim3(grid), dim3(NWAVES * 64), LDS_BYTES, stream, a);
#endif
}
```

```cpp
#include <hip/hip_runtime.h>
#include <cstdio>
#include <cstdint>
namespace pg8 {
#define PG8_LAS __attribute__((address_space(3)))
typedef unsigned short bf16_t;
typedef short bf16x8 __attribute__((ext_vector_type(8)));
typedef float f32x4 __attribute__((ext_vector_type(4)));
typedef unsigned u32x4 __attribute__((ext_vector_type(4)));
constexpr int BM = 256, BK = 64, HALF = 128, HTB = HALF * BK * 2  , STAGE_BYTES = 8 * HTB, NXCD = 8, WGM = 8;

__host__ __device__ __forceinline__ int lds_byte(int r, int c) { const int st = (r >> 4) * 2 + (c >> 5), rr = r & 15, cc = c & 31, ob = rr * 64 + cc * 2; return st * 1024 + (ob ^ (((ob >> 9) & 1) << 5)); }
__host__ __device__ __forceinline__ void stage_rc(int b, int& R, int& C) { const int st = b / 1024, sb = b % 1024, swz = sb ^ (((sb >> 9) & 1) << 5); R = (st >> 1) * 16 + swz / 64; C = (st & 1) * 32 + (swz % 64) / 2; }
__host__ __device__ __forceinline__ int perm32(int rho) { const int n = rho >> 4, i = rho & 15; return 8 * (i >> 2) + 4 * n + (i & 3); }

struct Unit { int pm, pn; };
struct Gemm { const bf16_t* A; const bf16_t* Bt; int M, N, K; };

struct StaticOrder {
    int nM, nN, nwg, G, c;
    __host__ __device__ void init(int M, int N, int G_, int c_) { nM = M / BM; nN = N / BM; nwg = nM * nN; G = G_; c = c_; }
    __host__ __device__ bool next(int i, Unit& u) const {
        const long L = (long)i * G + c; if (L >= nwg) return false;
        int wgid = (int)L; { const int q = nwg / NXCD, r = nwg % NXCD, xcd = wgid % NXCD, off = wgid / NXCD; wgid = (xcd < r ? xcd * (q + 1) : r * (q + 1) + (xcd - r) * q) + off; }
        const int nig = WGM * nN, gid = wgid / nig, fm = gid * WGM, gsz = (nM - fm) < WGM ? (nM - fm) : WGM;
        u.pm = fm + ((wgid % nig) % gsz); u.pn = (wgid % nig) / gsz; return true;
    }
    __device__ __forceinline__ void a_ready(const Unit&) const {}
    __device__ __forceinline__ void done(const Unit&) const {}
};


__device__ __forceinline__ void map_tile(int L, int nM, int nN, int& pm, int& pn) {
    const int nwg = nM * nN; int wgid = L;
    { const int q = nwg / NXCD, r = nwg % NXCD, xcd = wgid % NXCD, off = wgid / NXCD; wgid = (xcd < r ? xcd * (q + 1) : r * (q + 1) + (xcd - r) * q) + off; }
    const int nig = WGM * nN, gid = wgid / nig, fm = gid * WGM, gsz = (nM - fm) < WGM ? (nM - fm) : WGM;
    pm = fm + ((wgid % nig) % gsz); pn = (wgid % nig) / gsz;
}

__device__ __forceinline__ unsigned cvt_pk_bf16(float lo, float hi) { unsigned r; asm volatile("v_cvt_pk_bf16_f32 %0, %1, %2" : "=v"(r) : "v"(lo), "v"(hi)); return r; }

__device__ __forceinline__ float gelu_tanh_f(float x) {
    const float z2 = x * (1.5957691216f + 0.0713548163f * x * x);
    return x * __builtin_amdgcn_rcpf(1.0f + __builtin_amdgcn_exp2f(-1.4426950409f * z2));
}
__device__ __forceinline__ float silu_f(float x) { return x * __builtin_amdgcn_rcpf(1.0f + __builtin_amdgcn_exp2f(-1.4426950409f * x)); }

typedef int i32x4v __attribute__((ext_vector_type(4)));
typedef int i32x8v __attribute__((ext_vector_type(8)));
__host__ __device__ __forceinline__ int swz8(int rr) { return ((rr >> 1) & 1) | (((rr >> 3) & 1) << 2); }
__host__ __device__ __forceinline__ int lds_byte8(int r, int ch) { return (r >> 4) * 2048 + (r & 15) * 128 + ((ch ^ swz8(r & 15)) << 4); }
__host__ __device__ __forceinline__ void stage_rc8(int b, int& R, int& Cb) { const int st = b >> 11, rr = (b & 2047) >> 7, p = (b & 127) >> 4; R = st * 16 + rr; Cb = (p ^ swz8(rr)) << 4; }
__device__ __forceinline__ float clamp_fp8(float x) { return __builtin_fminf(__builtin_fmaxf(x, -448.0f), 448.0f); }
__device__ __forceinline__ unsigned pack4_fp8(float a, float b, float c, float d) { int w = 0; w = __builtin_amdgcn_cvt_pk_fp8_f32(clamp_fp8(a), clamp_fp8(b), w, false); w = __builtin_amdgcn_cvt_pk_fp8_f32(clamp_fp8(c), clamp_fp8(d), w, true); return (unsigned)w; }

template <int ACT> struct EpiBf16 {
    static constexpr bool PERM = true, AFTER_DRAIN = false;
    bf16_t* O; int ldc; int pn_mod; int rowoff; float scale;
    __device__ __forceinline__ void operator()(const f32x4 (&acc)[2][2][4][2], const Unit& u, int wr, int wc, int fr, int fq) const {
        const int row0 = rowoff + u.pm * BM + wr * 64 + fr; const int colt = (pn_mod ? (u.pn % pn_mod) : u.pn) * BM;
        const int col0 = colt + wc * 32 + 8 * fq;
#pragma unroll
        for (int ai = 0; ai < 2; ++ai)
#pragma unroll
            for (int m = 0; m < 4; ++m) { bf16_t* rowp = O + (size_t)(row0 + ai * HALF + m * 16) * ldc + col0;
#pragma unroll
                for (int bj = 0; bj < 2; ++bj) { f32x4 v0 = acc[ai][bj][m][0] * scale, v1 = acc[ai][bj][m][1] * scale;
                    if (ACT == 1) { v0 = (f32x4){gelu_tanh_f(v0[0]), gelu_tanh_f(v0[1]), gelu_tanh_f(v0[2]), gelu_tanh_f(v0[3])}; v1 = (f32x4){gelu_tanh_f(v1[0]), gelu_tanh_f(v1[1]), gelu_tanh_f(v1[2]), gelu_tanh_f(v1[3])}; }
                    u32x4 w; w.x = cvt_pk_bf16(v0[0], v0[1]); w.y = cvt_pk_bf16(v0[2], v0[3]); w.z = cvt_pk_bf16(v1[0], v1[1]); w.w = cvt_pk_bf16(v1[2], v1[3]);
                    *(u32x4*)(rowp + bj * HALF) = w; } }
    }
};
struct EpiSwiGLU {
    static constexpr bool PERM = true, AFTER_DRAIN = false;
    bf16_t* O; int ldc; int pn_mod; int rowoff;
    __device__ __forceinline__ void operator()(const f32x4 (&acc)[2][2][4][2], const Unit& u, int wr, int wc, int fr, int fq) const {
        const int row0 = rowoff + u.pm * BM + wr * 64 + fr; const int colt = (pn_mod ? (u.pn % pn_mod) : u.pn) * HALF;
        const int col0 = colt + wc * 32 + 8 * fq;
#pragma unroll
        for (int ai = 0; ai < 2; ++ai)
#pragma unroll
            for (int m = 0; m < 4; ++m) { bf16_t* rowp = O + (size_t)(row0 + ai * HALF + m * 16) * ldc + col0;
                const f32x4 g0 = acc[ai][0][m][0], g1 = acc[ai][0][m][1], u0 = acc[ai][1][m][0], u1 = acc[ai][1][m][1];
                u32x4 w; w.x = cvt_pk_bf16(silu_f(g0[0]) * u0[0], silu_f(g0[1]) * u0[1]); w.y = cvt_pk_bf16(silu_f(g0[2]) * u0[2], silu_f(g0[3]) * u0[3]);
                w.z = cvt_pk_bf16(silu_f(g1[0]) * u1[0], silu_f(g1[1]) * u1[1]); w.w = cvt_pk_bf16(silu_f(g1[2]) * u1[2], silu_f(g1[3]) * u1[3]);
                *(u32x4*)rowp = w; }
    }
};
struct EpiSwiGLU8 {
    static constexpr bool PERM = true, AFTER_DRAIN = false;
    unsigned char* O; int ldc; int pn_mod; int rowoff; float in_scale, out_scale;
    __device__ __forceinline__ void operator()(const f32x4 (&acc)[2][2][4][2], const Unit& u, int wr, int wc, int fr, int fq) const {
        typedef unsigned u32x2v __attribute__((ext_vector_type(2)));
        const int row0 = rowoff + u.pm * BM + wr * 64 + fr; const int colt = (pn_mod ? (u.pn % pn_mod) : u.pn) * HALF;
        const int col0 = colt + wc * 32 + 8 * fq;
#pragma unroll
        for (int ai = 0; ai < 2; ++ai)
#pragma unroll
            for (int m = 0; m < 4; ++m) { unsigned char* rowp = O + (size_t)(row0 + ai * HALF + m * 16) * ldc + col0;
                const f32x4 g0 = acc[ai][0][m][0] * in_scale, g1 = acc[ai][0][m][1] * in_scale, u0 = acc[ai][1][m][0] * (in_scale * out_scale), u1 = acc[ai][1][m][1] * (in_scale * out_scale);
                u32x2v w; w.x = pack4_fp8(silu_f(g0[0]) * u0[0], silu_f(g0[1]) * u0[1], silu_f(g0[2]) * u0[2], silu_f(g0[3]) * u0[3]);
                w.y = pack4_fp8(silu_f(g1[0]) * u1[0], silu_f(g1[1]) * u1[1], silu_f(g1[2]) * u1[2], silu_f(g1[3]) * u1[3]);
                *(u32x2v*)rowp = w; }
    }
};
struct EpiGeluT {
    static constexpr bool PERM = false, AFTER_DRAIN = false;
    bf16_t* VT; int nch;
    __device__ __forceinline__ void operator()(const f32x4 (&acc)[2][2][4][2], const Unit& u, int wr, int wc, int fr, int fq) const {
        typedef unsigned u32x2v __attribute__((ext_vector_type(2)));
#pragma unroll
        for (int ai = 0; ai < 2; ++ai) { const int chunk = 2 * u.pm + ai;
#pragma unroll
            for (int bj = 0; bj < 2; ++bj)
#pragma unroll
                for (int n = 0; n < 2; ++n) { const int ch = u.pn * BM + bj * HALF + wc * 32 + n * 16 + fr; bf16_t* cp = VT + ((size_t)chunk * nch + ch) * 128 + wr * 64 + 4 * fq;
#pragma unroll
                    for (int m = 0; m < 4; ++m) { const f32x4 v = acc[ai][bj][m][n]; u32x2v w; w.x = cvt_pk_bf16(gelu_tanh_f(v[0]), gelu_tanh_f(v[1])); w.y = cvt_pk_bf16(gelu_tanh_f(v[2]), gelu_tanh_f(v[3]));
                        *(u32x2v*)(cp + m * 16) = w; } } }
    }
};


struct GridOrder {
    int nM, nN, G, c;
    __device__ __forceinline__ bool next(int i, Unit& u) const { const int L = i * G + c; if (L >= nM * nN) return false; map_tile(L, nM, nN, u.pm, u.pn); return true; }
    __device__ __forceinline__ void a_ready(const Unit&) const {}
    __device__ __forceinline__ void done(const Unit&) const {}
};
struct InProjOrder {
    int nM, nN, nX, pnX, G, c;
    __device__ __forceinline__ bool next(int i, Unit& u) const { const int L = i * G + c, n0 = nM * nN; if (L < n0) { map_tile(L, nM, nN, u.pm, u.pn); return true; } if (L < n0 + nX) { u.pm = nM + (L - n0); u.pn = pnX; return true; } return false; }
    __device__ __forceinline__ void a_ready(const Unit&) const {}
    __device__ __forceinline__ void done(const Unit&) const {}
};
struct MoeOrder {
    int nM, nN, G, c, tile0; const PG8_LAS int* tile_e; int ibase, icount;
    __device__ __forceinline__ bool next(int i, Unit& u) const { if (i >= icount) return false; const int L = (ibase + i) * G + c; if (L >= nM * nN) return false; int pm, pn; map_tile(L, nM, nN, pm, pn); u.pm = pm; u.pn = tile_e[tile0 + pm] * nN + pn; return true; }
    __device__ __forceinline__ void a_ready(const Unit&) const {}
    __device__ __forceinline__ void done(const Unit&) const {}
};
template <class Epi, class Sched, bool ALIGN_EPI, bool SWAP, bool GATHER, bool FP8 = false>
__device__ __forceinline__ void gemm_phase(PG8_LAS unsigned char* lds, const Gemm g, const Sched& S, const Epi& E, const PG8_LAS int* idxtab) {
    const int tid = threadIdx.x, wid = __builtin_amdgcn_readfirstlane(tid >> 6), lane = tid & 63, wr = wid >> 2, wc = wid & 3, fr = lane & 15, fq = lane >> 4;
    const int K = g.K, Kb = FP8 ? K : 2 * K, nt = Kb / 128;
    unsigned voffB[2], vc0[2], vc1[2], vn0[2], vn1[2]; int RA[2], CA[2];
#pragma unroll
    for (int i = 0; i < 2; ++i) { int R, C; if constexpr (FP8) stage_rc8(tid * 16 + i * 8192, R, C); else { stage_rc(tid * 16 + i * 8192, R, C); C *= 2; } const int Rb = Epi::PERM ? ((R & ~31) + perm32(R & 31)) : R;
        RA[i] = R; CA[i] = C  ; voffB[i] = (unsigned)(Rb * Kb + C); vc0[i] = vc1[i] = vn0[i] = vn1[i] = (unsigned)(R * Kb + C); }
    const size_t kstep = (size_t)128;
    const size_t hstep = (size_t)HALF * Kb;
    const size_t tstep = 2 * hstep;
    const size_t hstepA = GATHER ? (size_t)0 : hstep;
    const unsigned ldsw = (unsigned)wid * 1024u;
    const int aoff = FP8 ? lds_byte8(wr * 64 + fr, 2 * fq) : lds_byte(wr * 64 + fr, fq * 8), boff = FP8 ? lds_byte8(wc * 32 + fr, 2 * fq) : lds_byte(wc * 32 + fr, fq * 8);
    const int aoff1 = lds_byte8(wr * 64 + fr, 2 * fq + 1), boff1 = lds_byte8(wc * 32 + fr, 2 * fq + 1);
#define PG8_SA(b, h) (((b) * 2 + (h)) * HTB)
#define PG8_SB(b, h) ((4 + (b) * 2 + (h)) * HTB)
#define PG8_STAGE(bufoff, gbase, voff) do { _Pragma("unroll") for (int _i = 0; _i < 2; ++_i) \
        __builtin_amdgcn_global_load_lds((const unsigned*)((const char*)(gbase) + (voff)[_i]), (PG8_LAS unsigned*)(lds + (bufoff) + ldsw + _i * 8192), 16, 0, 0); } while (0)
#define PG8_LDA(dst, b, h) do { if constexpr (FP8) { _Pragma("unroll") for (int m = 0; m < 4; ++m) { const i32x4v lo_ = *(const PG8_LAS i32x4v*)(lds + PG8_SA(b, h) + aoff + m * 2048), hi_ = *(const PG8_LAS i32x4v*)(lds + PG8_SA(b, h) + aoff1 + m * 2048); dst##8[m] = __builtin_shufflevector(lo_, hi_, 0, 1, 2, 3, 4, 5, 6, 7); } } \
    else { _Pragma("unroll") for (int m = 0; m < 4; ++m) _Pragma("unroll") for (int k = 0; k < 2; ++k) dst[m][k] = *(const PG8_LAS bf16x8*)(lds + PG8_SA(b, h) + aoff + m * 2048 + k * 1024); } } while (0)
#define PG8_LDB(dst, b, h) do { if constexpr (FP8) { _Pragma("unroll") for (int n = 0; n < 2; ++n) { const i32x4v lo_ = *(const PG8_LAS i32x4v*)(lds + PG8_SB(b, h) + boff + n * 2048), hi_ = *(const PG8_LAS i32x4v*)(lds + PG8_SB(b, h) + boff1 + n * 2048); dst##8[n] = __builtin_shufflevector(lo_, hi_, 0, 1, 2, 3, 4, 5, 6, 7); } } \
    else { _Pragma("unroll") for (int n = 0; n < 2; ++n) _Pragma("unroll") for (int k = 0; k < 2; ++k) dst[n][k] = *(const PG8_LAS bf16x8*)(lds + PG8_SB(b, h) + boff + n * 2048 + k * 1024); } } while (0)
#define PG8_MMA(ai, bj, At, Bt) do { __builtin_amdgcn_s_setprio(1); if constexpr (FP8) { _Pragma("unroll") for (int m = 0; m < 4; ++m) _Pragma("unroll") for (int n = 0; n < 2; ++n) \
        asm volatile("v_mfma_f32_16x16x128_f8f6f4 %0, %1, %2, %0" : "+v"(acc[ai][bj][m][n]) : "v"(Bt##8[n]), "v"(At##8[m])); } \
    else { _Pragma("unroll") for (int m = 0; m < 4; ++m) _Pragma("unroll") for (int n = 0; n < 2; ++n) _Pragma("unroll") for (int k = 0; k < 2; ++k) \
        acc[ai][bj][m][n] = SWAP ? __builtin_amdgcn_mfma_f32_16x16x32_bf16(At[m][k], Bt[n][k], acc[ai][bj][m][n], 0, 0, 0) : __builtin_amdgcn_mfma_f32_16x16x32_bf16(Bt[n][k], At[m][k], acc[ai][bj][m][n], 0, 0, 0); } __builtin_amdgcn_s_setprio(0); } while (0)
#define PG8_WAIT_V(n) asm volatile("s_waitcnt vmcnt(" #n ")" ::: "memory")
#define PG8_WAIT_L(n) asm volatile("s_waitcnt lgkmcnt(" #n ")" ::: "memory")
#define PG8_BAR __builtin_amdgcn_s_barrier()
#define PG8_SCHED __builtin_amdgcn_sched_barrier(0)
    Unit cur, nxt; int ui = 0;
    if (!S.next(0, cur)) return;
    if constexpr (GATHER) {
#pragma unroll
        for (int i = 0; i < 2; ++i) { vc0[i] = (unsigned)(idxtab[RA[i]] * Kb + CA[i]); vc1[i] = (unsigned)(idxtab[HALF + RA[i]] * Kb + CA[i]); vn0[i] = vc0[i]; vn1[i] = vc1[i]; }
    }
    f32x4 acc[2][2][4][2];
#pragma unroll
    for (int a = 0; a < 2; ++a)
#pragma unroll
        for (int b = 0; b < 2; ++b)
#pragma unroll
            for (int m = 0; m < 4; ++m)
#pragma unroll
                for (int n = 0; n < 2; ++n) acc[a][b][m][n] = (f32x4){0.f, 0.f, 0.f, 0.f};
    bf16x8 At[4][2], B0[2][2], B1[2][2]; i32x8v At8[4], B08[2], B18[2];
    const char* cA = GATHER ? (const char*)g.A : (const char*)g.A + (size_t)cur.pm * tstep; const char* cB = (const char*)g.Bt + (size_t)cur.pn * tstep;
    S.a_ready(cur);
    PG8_STAGE(PG8_SB(0, 0), cB, voffB); PG8_STAGE(PG8_SB(0, 1), cB + hstep, voffB); PG8_STAGE(PG8_SA(0, 0), cA, vc0); PG8_STAGE(PG8_SA(0, 1), cA + hstepA, vc1);
    if (wr == 1) PG8_BAR;
    PG8_WAIT_V(2); PG8_BAR;
    PG8_STAGE(PG8_SB(1, 0), cB + kstep, voffB); PG8_STAGE(PG8_SA(1, 0), cA + kstep, vc0); PG8_STAGE(PG8_SB(1, 1), cB + hstep + kstep, voffB);
    PG8_WAIT_V(6); PG8_BAR;
    for (;;) {
        const bool has_next = S.next(ui + 1, nxt);
        const char* nA = GATHER ? cA : (has_next ? (const char*)g.A + (size_t)nxt.pm * tstep : cA); const char* nB = has_next ? (const char*)g.Bt + (size_t)nxt.pn * tstep : cB;
#pragma unroll 1
        for (int t = 0; t < nt; t += 2) {
            const bool last = (t == nt - 2);
            const char* a1 = cA + (size_t)(t + 1) * kstep;
            const char* a2 = last ? nA : cA + (size_t)(t + 2) * kstep; const char* b2 = last ? nB : cB + (size_t)(t + 2) * kstep;
            const char* a3 = a2 + kstep; const char* b3 = b2 + kstep;
            unsigned w0[2], w1[2];
            if constexpr (GATHER) {
                if (last && has_next) {
                    int tl = tid; asm volatile("" : "+v"(tl));
#pragma unroll
                    for (int i = 0; i < 2; ++i) { int R, C; if constexpr (FP8) stage_rc8(tl * 16 + i * 8192, R, C); else { stage_rc(tl * 16 + i * 8192, R, C); C *= 2; }
                        vn0[i] = (unsigned)(idxtab[(ui + 1) * BM + R] * Kb + C); vn1[i] = (unsigned)(idxtab[(ui + 1) * BM + HALF + R] * Kb + C); }
                }
            }
#pragma unroll
            for (int i = 0; i < 2; ++i) { w0[i] = (GATHER && last) ? vn0[i] : vc0[i]; w1[i] = (GATHER && last) ? vn1[i] : vc1[i]; }
            if (last && has_next) S.a_ready(nxt);
            PG8_LDB(B0, 0, 0); PG8_LDB(B1, 0, 1); PG8_SCHED; PG8_LDA(At, 0, 0); PG8_STAGE(PG8_SA(1, 1), a1 + hstepA, vc1);
            PG8_WAIT_V(8); PG8_WAIT_L(0); PG8_BAR; PG8_MMA(0, 0, At, B0); PG8_MMA(0, 1, At, B1); PG8_BAR; PG8_SCHED;
            PG8_LDA(At, 0, 1); PG8_STAGE(PG8_SB(0, 0), b2, voffB); PG8_STAGE(PG8_SB(0, 1), b2 + hstep, voffB); PG8_STAGE(PG8_SA(0, 0), a2, w0);
            PG8_WAIT_V(8); PG8_WAIT_L(0); PG8_BAR; PG8_MMA(1, 0, At, B0); PG8_MMA(1, 1, At, B1); PG8_BAR; PG8_SCHED;
            PG8_LDB(B0, 1, 0); PG8_LDB(B1, 1, 1); PG8_SCHED; PG8_LDA(At, 1, 0); PG8_STAGE(PG8_SA(0, 1), a2 + hstepA, w1);
            PG8_WAIT_V(8); PG8_WAIT_L(0); PG8_BAR; PG8_MMA(0, 0, At, B0); PG8_MMA(0, 1, At, B1); PG8_BAR; PG8_SCHED;
            PG8_LDA(At, 1, 1); PG8_STAGE(PG8_SB(1, 0), b3, voffB); PG8_STAGE(PG8_SB(1, 1), b3 + hstep, voffB); PG8_STAGE(PG8_SA(1, 0), a3, w0);
            PG8_WAIT_V(8); PG8_WAIT_L(0); PG8_BAR; PG8_MMA(1, 0, At, B0); PG8_MMA(1, 1, At, B1); PG8_BAR; PG8_SCHED;
        }
        if constexpr (ALIGN_EPI) { if (wr == 0) PG8_BAR; }
        if constexpr (FP8) asm volatile("s_nop 15\n\ts_nop 7" ::: "memory");
        E(acc, cur, wr, wc, fr, fq); S.done(cur);
        if (!has_next) break;
#pragma unroll
        for (int a = 0; a < 2; ++a)
#pragma unroll
            for (int b = 0; b < 2; ++b)
#pragma unroll
                for (int m = 0; m < 4; ++m)
#pragma unroll
                    for (int n = 0; n < 2; ++n) acc[a][b][m][n] = (f32x4){0.f, 0.f, 0.f, 0.f};
        cur = nxt; cA = nA; cB = nB; ++ui;
#pragma unroll
        for (int i = 0; i < 2; ++i) { vc0[i] = vn0[i]; vc1[i] = vn1[i]; }
        if constexpr (ALIGN_EPI) { if (wr == 1) PG8_BAR; }
    }
    PG8_WAIT_V(0);
    if constexpr (!ALIGN_EPI) { if (wr == 0) PG8_BAR; }
    PG8_BAR;
#undef PG8_SA
#undef PG8_SB
#undef PG8_STAGE
#undef PG8_LDA
#undef PG8_LDB
#undef PG8_MMA
#undef PG8_WAIT_V
#undef PG8_WAIT_L
#undef PG8_BAR
#undef PG8_SCHED
}
}
#include <hip/hip_bf16.h>
#include <cmath>
namespace attn_body {
using bf16=__hip_bfloat16;
using bf16x8=__attribute__((ext_vector_type(8)))short;
using s16x4=__attribute__((ext_vector_type(4)))short;
using f32x16=__attribute__((ext_vector_type(16)))float;
using u32x4=__attribute__((ext_vector_type(4)))unsigned;
constexpr int NHEAD=8,NKVH=2,SEQ=8192,SKV=8448,D=64,QP=512,KP=128,OP=1024;
constexpr int NW=8,QBLK=32,QB=QBLK*NW,KVBLK=64,NQB=SEQ/QB,NT=SKV/KVBLK;
constexpr int ATTN_UNIT_ROWS=QB;
__device__ __forceinline__ int crow(int r,int hi){return (r&3)+8*(r>>2)+4*hi;}
#define SBAR() __builtin_amdgcn_sched_barrier(0)
__device__ __forceinline__ void cmask(f32x16&p0,f32x16&p1,int jb,int qrel,int hi){
  const float NEG=-INFINITY; int kb=64*jb+4*hi;
  #pragma unroll
  for(int r=0;r<16;++r){int kv=kb+(r&3)+8*(r>>2); if(kv>qrel)p0[r]=NEG; if(kv+32>qrel)p1[r]=NEG;}
}

constexpr int NSLOT=3, SLOTB=8192;
constexpr int LDS_K=0, LDS_V=NSLOT*SLOTB, LDS_WS=2*NSLOT*SLOTB, LDS_OST=LDS_WS+NW*64*4, LDS_BYTES=LDS_OST+NW*4096;
constexpr float C2=0.125f*1.4426950408889634f;
__device__ __forceinline__ void glds16(const void*gsrc,unsigned lds_dst){unsigned keep;
  asm volatile("s_mov_b32 %0, m0\n\ts_mov_b32 m0, %2\n\ts_nop 0\n\tglobal_load_lds_dwordx4 %1, off\n\ts_mov_b32 m0, %0":"=&s"(keep):"v"(gsrc),"s"(lds_dst):"memory");}
__device__ __forceinline__ float max3f(float a,float b,float c){float r;asm("v_max3_f32 %0, %1, %2, %3":"=v"(r):"v"(a),"v"(b),"v"(c));return r;}
__device__ __forceinline__ float max2f(float a,float b){float r;asm("v_max_f32_e32 %0, %1, %2":"=v"(r):"v"(a),"v"(b));return r;}
__device__ __forceinline__ float fadd_s(float a,float b){float r;asm("v_add_f32_e32 %0, %1, %2":"=v"(r):"v"(a),"v"(b));return r;}
__device__ __forceinline__ float fsub_s(float a,float b){float r;asm("v_sub_f32_e32 %0, %1, %2":"=v"(r):"v"(a),"v"(b));return r;}
typedef float f32x2_t __attribute__((ext_vector_type(2))); typedef __bf16 bf16x2_t __attribute__((ext_vector_type(2)));
__device__ __forceinline__ unsigned cvtpk_s(float lo,float hi){f32x2_t v={lo,hi};bf16x2_t b=__builtin_convertvector(v,bf16x2_t);return __builtin_bit_cast(unsigned,b);}
#define WAIT_BAR(N) asm volatile("s_waitcnt vmcnt(" #N ") lgkmcnt(0)\n\ts_barrier":::"memory")

__device__ __forceinline__ void qkt(f32x16&p0,f32x16&p1,const char*Kslot,const bf16x8*qr,const f32x16&negm,int r32,int hi){
  const char*kb=Kslot+hi*1024+r32*16;
  #pragma unroll
  for(int d0=0;d0<4;++d0){
    const bf16x8 b0=*reinterpret_cast<const bf16x8*>(kb+d0*2048);
    const bf16x8 b1=*reinterpret_cast<const bf16x8*>(kb+d0*2048+512);
    if(d0==0){p0=__builtin_amdgcn_mfma_f32_32x32x16_bf16(b0,qr[0],negm,0,0,0);p1=__builtin_amdgcn_mfma_f32_32x32x16_bf16(b1,qr[0],negm,0,0,0);}
    else{p0=__builtin_amdgcn_mfma_f32_32x32x16_bf16(b0,qr[d0],p0,0,0,0);p1=__builtin_amdgcn_mfma_f32_32x32x16_bf16(b1,qr[d0],p1,0,0,0);}}
}
typedef __attribute__((address_space(3))) const char* lds_cptr;
typedef short v4i16_t __attribute__((ext_vector_type(4)));
__device__ __forceinline__ void kload8(bf16x8*kf,lds_cptr kp){
  kf[0]=*(const __attribute__((address_space(3))) bf16x8*)(kp);      kf[1]=*(const __attribute__((address_space(3))) bf16x8*)(kp+512);
  kf[2]=*(const __attribute__((address_space(3))) bf16x8*)(kp+2048); kf[3]=*(const __attribute__((address_space(3))) bf16x8*)(kp+2560);
  kf[4]=*(const __attribute__((address_space(3))) bf16x8*)(kp+4096); kf[5]=*(const __attribute__((address_space(3))) bf16x8*)(kp+4608);
  kf[6]=*(const __attribute__((address_space(3))) bf16x8*)(kp+6144); kf[7]=*(const __attribute__((address_space(3))) bf16x8*)(kp+6656);
}
__device__ __forceinline__ void kload2(bf16x8*kf,lds_cptr kp,int j){ kf[2*j]=*(const __attribute__((address_space(3))) bf16x8*)(kp+j*2048); kf[2*j+1]=*(const __attribute__((address_space(3))) bf16x8*)(kp+j*2048+512); }
__device__ __forceinline__ s16x4 vtr(lds_cptr p){ return __builtin_bit_cast(s16x4,__builtin_amdgcn_ds_read_tr16_b64_v4i16((__attribute__((address_space(3))) v4i16_t*)p)); }
__device__ __forceinline__ float rowmax(const f32x16&p0,const f32x16&p1){
  float a=max3f(p0[0],p0[1],p1[0]),b=max3f(p0[2],p0[3],p1[1]);a=max3f(a,p1[2],p1[3]);
  #pragma unroll
  for(int r=4;r<16;r+=4){a=max3f(a,p0[r],p0[r+1]);b=max3f(b,p0[r+2],p0[r+3]);a=max3f(a,p1[r],p1[r+1]);b=max3f(b,p1[r+2],p1[r+3]);}
  const float m=max2f(a,b);
  auto rr=__builtin_amdgcn_permlane32_swap(__float_as_uint(m),__float_as_uint(m),false,false);
  return max2f(__uint_as_float(rr[0]),__uint_as_float(rr[1]));
}
__device__ __forceinline__ void pv(f32x16*o,int vb,bf16x8 pa0,bf16x8 pa1,bf16x8 pa2,bf16x8 pa3){
  #pragma unroll
  for(int d0=0;d0<2;++d0){s16x4 lo[4],hi[4];
    #pragma unroll
    for(int ks=0;ks<4;++ks){
      asm volatile("ds_read_b64_tr_b16 %0,%1 offset:%c2":"=&v"(lo[ks]):"v"(vb),"i"(d0*4096+ks*1024):"memory");
      asm volatile("ds_read_b64_tr_b16 %0,%1 offset:%c2":"=&v"(hi[ks]):"v"(vb),"i"(d0*4096+ks*1024+512):"memory");}
    asm volatile("s_waitcnt lgkmcnt(0)":::"memory");SBAR();
    #define PK(k) (bf16x8){lo[k][0],lo[k][1],lo[k][2],lo[k][3],hi[k][0],hi[k][1],hi[k][2],hi[k][3]}
    o[d0]=__builtin_amdgcn_mfma_f32_32x32x16_bf16(pa0,PK(0),o[d0],0,0,0);
    o[d0]=__builtin_amdgcn_mfma_f32_32x32x16_bf16(pa1,PK(1),o[d0],0,0,0);
    o[d0]=__builtin_amdgcn_mfma_f32_32x32x16_bf16(pa2,PK(2),o[d0],0,0,0);
    o[d0]=__builtin_amdgcn_mfma_f32_32x32x16_bf16(pa3,PK(3),o[d0],0,0,0);
    #undef PK
  }
}

#ifndef ATTN_STORE16
#define ATTN_STORE16(p,v) (*(u32x4*)(p)=(v))
#endif
template<int THRL> __device__ __forceinline__ void attn_unit(int b,int h,int qb,const bf16*Q,const bf16*__restrict__ K,const bf16*__restrict__ V,bf16*O,char*shm){
  const int tid=threadIdx.x,lane=tid&63,r32=lane&31,hi=lane>>5; const int wid=__builtin_amdgcn_readfirstlane(tid>>6);
  const long rowbase=(long)b*SEQ; const int q0=qb*QB; const int kvh=h/(NHEAD/NKVH);
  const bf16*Qw=Q+(rowbase+q0+wid*QBLK)*QP+h*D;
  const bf16*Kh=K+(long)b*SKV*KP+kvh*D,*Vh=V+(long)b*SKV*KP+kvh*D;
  const unsigned lds0=(unsigned)(uintptr_t)shm;
  float*wsf=(float*)(shm+LDS_WS)+wid*64;
  const bf16*ksrc=Kh+(long)lane*KP+wid*8;
  const bf16*vsrc=Vh+(long)(16*(wid&3)+(lane>>2))*KP+(wid>>2)*32+(lane&3)*8;
  const unsigned kdst=lds0+LDS_K+wid*1024, vdst=lds0+LDS_V+wid*1024;
  #define DMA_K(t,slot) glds16(ksrc+(long)(t)*KVBLK*KP,(unsigned)__builtin_amdgcn_readfirstlane(kdst+(slot)))
  #define DMA_V(t,slot) glds16(vsrc+(long)(t)*KVBLK*KP,(unsigned)__builtin_amdgcn_readfirstlane(vdst+(slot)))
  const int vb0=(int)(lds0+LDS_V)+((lane>>4)&1)*32+(lane&3)*8+(4*hi+((lane&15)>>2))*64;
  const char*Kbase=shm+LDS_K; bf16x8 kf[8];
  const lds_cptr shm3=(lds_cptr)shm; const lds_cptr kp0=shm3+LDS_K+hi*1024+r32*16; const lds_cptr vp0=shm3+LDS_V+((lane>>4)&1)*32+(lane&3)*8+(4*hi+((lane&15)>>2))*64;
  DMA_K(0,0);DMA_V(0,0);DMA_K(1,SLOTB);
  bf16x8 qr[4];
  #pragma unroll
  for(int d0=0;d0<4;++d0)qr[d0]=*reinterpret_cast<const bf16x8*>(&Qw[(long)r32*QP+d0*16+hi*8]);
  float mhat=0.f,l_reg=0.f;f32x16 o[2];o[0]=f32x16{};o[1]=f32x16{};f32x16 negm=f32x16{};asm volatile("":"+v"(negm));
  #define CMASK(P0,P1,t) do{}while(0)
  bool resc=false;
  #define START(P0,P1) do{ const float rm=rowmax(P0,P1); resc=false; \
    { const float dl=rm; mhat=fadd_s(mhat,dl); \
      _Pragma("unroll") for(int r=0;r<16;++r){P0[r]=fsub_s(P0[r],dl);P1[r]=fsub_s(P1[r],dl);} \
      _Pragma("unroll") for(int r=0;r<16;++r)negm[r]=-mhat; asm volatile("":"+v"(negm)); } \
    _Pragma("unroll") for(int r=0;r<16;++r)P0[r]=__builtin_amdgcn_exp2f(P0[r]); }while(0)
  #define RESC() do{ if(resc){ asm volatile("s_waitcnt lgkmcnt(0)":::"memory"); \
      _Pragma("unroll") for(int d_=0;d_<2;++d_) _Pragma("unroll") for(int r=0;r<16;++r)o[d_][r]*=wsf[crow(r,hi)]; } }while(0)
  f32x16 pA0,pA1,pB0,pB1;
  int sl_prev=0,sl_cur=0,sl_next=SLOTB;
  #define ROT() do{sl_prev=sl_cur;sl_cur=sl_next;sl_next=(sl_next==(NSLOT-1)*SLOTB)?0:sl_next+SLOTB;}while(0)
  DMA_K(2,2*SLOTB);
  WAIT_BAR(3);
  qkt(pA0,pA1,Kbase,qr,negm,r32,hi);asm volatile("s_nop 15\n\ts_nop 7":"+v"(pA0),"+v"(pA1));CMASK(pA0,pA1,0);
  START(pA0,pA1);
  _Pragma("unroll") for(int r=0;r<16;++r)pA1[r]=__builtin_amdgcn_exp2f(pA1[r]);
  WAIT_BAR(0);
  DMA_K(3,0);DMA_V(1,SLOTB);
  ROT();
  kload8(kf,kp0+sl_cur);
  WAIT_BAR(2);
  s16x4 vlo[8],vhi[8]; u32x4 pw0,pw1,pw2,pw3;
  #define PKW(P,B) cvtpk_s(P[B],P[B+1])
  #define PAF(k) __builtin_bit_cast(bf16x8,pw##k)
  #define VFR(i) (bf16x8){vlo[i][0],vlo[i][1],vlo[i][2],vlo[i][3],vhi[i][0],vhi[i][1],vhi[i][2],vhi[i][3]}
  #define PIN(x) asm volatile("":"+v"(x))
  #define MX3(a,b,c) __builtin_fmaxf(__builtin_fmaxf((a),(b)),(c))
  #define GAPA(MF,A0,A1,A2,A3,W0,W1,PW) do{ MF; sacc+=A0; sacc+=A1; sacc+=A2; sacc+=A3; PIN(sacc); W0; W1; PIN(PW); SBAR(); }while(0)
  #define EX(v) __builtin_amdgcn_exp2f(v)
  #define GAPB(MF,X,B) do{ MF; X[B]=EX(X[B]); X[B+1]=EX(X[B+1]); X[B+2]=EX(X[B+2]); X[B+3]=EX(X[B+3]); PIN(X); SBAR(); }while(0)
  #define VRD(i) do{ vlo[i]=vtr(vp_+(((i)>>2)*4096+((i)&3)*1024)); vhi[i]=vtr(vp_+(((i)>>2)*4096+((i)&3)*1024+512)); }while(0)
  #define KRD(G,j) do{ if(G){ kload2(kf,kp0+sl_next,j); SBAR(); } }while(0)
  #define STEP(C0,C1,P0,P1,t,GK,GV,GL) do{ SBAR(); \
    const lds_cptr vp_=vp0+sl_prev; \
    VRD(0); SBAR(); float sacc=(P0[0]+P0[1]); \
    GAPA(C0=__builtin_amdgcn_mfma_f32_32x32x16_bf16(kf[0],qr[0],negm,0,0,0), P0[2],P0[3],P0[4],P0[5],     pw0[0]=PKW(P0,0), pw0[1]=PKW(P0,2), pw0); \
    VRD(4); SBAR(); GAPA(C1=__builtin_amdgcn_mfma_f32_32x32x16_bf16(kf[1],qr[0],negm,0,0,0), P0[6],P0[7],P0[8],P0[9],     pw0[2]=PKW(P0,4), pw0[3]=PKW(P0,6), pw0); \
    VRD(1); SBAR(); GAPA(C0=__builtin_amdgcn_mfma_f32_32x32x16_bf16(kf[2],qr[1],C0,0,0,0),   P0[10],P0[11],P0[12],P0[13], pw1[0]=PKW(P0,8), pw1[1]=PKW(P0,10), pw1); \
    VRD(5); SBAR(); GAPA(C1=__builtin_amdgcn_mfma_f32_32x32x16_bf16(kf[3],qr[1],C1,0,0,0),   P0[14],P0[15],P1[0],P1[1],   pw1[2]=PKW(P0,12),pw1[3]=PKW(P0,14), pw1); \
    VRD(2); SBAR(); GAPA(C0=__builtin_amdgcn_mfma_f32_32x32x16_bf16(kf[4],qr[2],C0,0,0,0),   P1[2],P1[3],P1[4],P1[5],     pw2[0]=PKW(P1,0), pw2[1]=PKW(P1,2), pw2); \
    VRD(6); SBAR(); GAPA(C1=__builtin_amdgcn_mfma_f32_32x32x16_bf16(kf[5],qr[2],C1,0,0,0),   P1[6],P1[7],P1[8],P1[9],     pw2[2]=PKW(P1,4), pw2[3]=PKW(P1,6), pw2); \
    VRD(3); SBAR(); GAPA(C0=__builtin_amdgcn_mfma_f32_32x32x16_bf16(kf[6],qr[3],C0,0,0,0),   P1[10],P1[11],P1[12],P1[13], pw3[0]=PKW(P1,8), pw3[1]=PKW(P1,10), pw3); \
    VRD(7); SBAR(); GAPA(C1=__builtin_amdgcn_mfma_f32_32x32x16_bf16(kf[7],qr[3],C1,0,0,0),   P1[14],P1[15],0.f,0.f,       pw3[2]=PKW(P1,12),pw3[3]=PKW(P1,14), pw3); \
    l_reg+=sacc; \
    if(GK){DMA_K((t)+3,sl_cur);} if(GV){DMA_V((t)+1,sl_next);} \
    CMASK(C0,C1,t); \
    { float a=MX3(C0[0],C0[1],C1[0]),b=MX3(C0[2],C0[3],C1[1]); a=MX3(a,C1[2],C1[3]); \
      _Pragma("unroll") for(int r=4;r<16;r+=4){a=MX3(a,C0[r],C0[r+1]);b=MX3(b,C0[r+2],C0[r+3]);a=MX3(a,C1[r],C1[r+1]);b=MX3(b,C1[r+2],C1[r+3]);} \
      float rm=__builtin_fmaxf(a,b); { auto rr=__builtin_amdgcn_permlane32_swap(__float_as_uint(rm),__float_as_uint(rm),false,false); rm=__builtin_fmaxf(__uint_as_float(rr[0]),__uint_as_float(rr[1])); } \
      resc=false; \
      if(__builtin_expect(__any(rm>(float)THRL),0)){ const float dl=__builtin_fmaxf(rm,0.f); mhat+=dl; \
        _Pragma("unroll") for(int r=0;r<16;++r){C0[r]-=dl;C1[r]-=dl;} \
        _Pragma("unroll") for(int r=0;r<16;++r)negm[r]=-mhat; asm volatile("":"+v"(negm)); \
        const float f=__builtin_amdgcn_exp2f(-dl); l_reg*=f; if(hi==0)wsf[r32]=f; resc=true; } } \
    SBAR(); \
    GAPB(o[0]=__builtin_amdgcn_mfma_f32_32x32x16_bf16(PAF(0),VFR(0),o[0],0,0,0), C0,0); \
    GAPB(o[1]=__builtin_amdgcn_mfma_f32_32x32x16_bf16(PAF(0),VFR(4),o[1],0,0,0), C0,4); \
    KRD(GL,0); GAPB(o[0]=__builtin_amdgcn_mfma_f32_32x32x16_bf16(PAF(1),VFR(1),o[0],0,0,0), C0,8); \
    KRD(GL,1); GAPB(o[1]=__builtin_amdgcn_mfma_f32_32x32x16_bf16(PAF(1),VFR(5),o[1],0,0,0), C0,12); \
    KRD(GL,2); GAPB(o[0]=__builtin_amdgcn_mfma_f32_32x32x16_bf16(PAF(2),VFR(2),o[0],0,0,0), C1,0); \
    KRD(GL,3); GAPB(o[1]=__builtin_amdgcn_mfma_f32_32x32x16_bf16(PAF(2),VFR(6),o[1],0,0,0), C1,4); \
    GAPB(o[0]=__builtin_amdgcn_mfma_f32_32x32x16_bf16(PAF(3),VFR(3),o[0],0,0,0), C1,8); \
    GAPB(o[1]=__builtin_amdgcn_mfma_f32_32x32x16_bf16(PAF(3),VFR(7),o[1],0,0,0), C1,12); \
    }while(0)
  int t=1;
  #undef CMASK
  #define CMASK(P0,P1,t) do{}while(0)
  for(;t+5<NT;t+=2){
    STEP(pB0,pB1,pA0,pA1,t,true,true,true);     WAIT_BAR(2); RESC(); ROT();
    STEP(pA0,pA1,pB0,pB1,t+1,true,true,true);   WAIT_BAR(2); RESC(); ROT();
  }
  #undef CMASK
  #define CMASK(P0,P1,t) do{}while(0)
  #define ENDW(tt) do{ if((tt)+3<NT){WAIT_BAR(2);} else if((tt)+2<NT){WAIT_BAR(1);} else {WAIT_BAR(0);} }while(0)
  for(;t+1<NT;t+=2){
    STEP(pB0,pB1,pA0,pA1,t,(t+3<NT),(t+1<NT),(t+1<NT));       ENDW(t);   RESC(); ROT();
    STEP(pA0,pA1,pB0,pB1,t+1,(t+4<NT),(t+2<NT),(t+2<NT));     ENDW(t+1); RESC(); ROT();
  }
  STEP(pB0,pB1,pA0,pA1,NT-1,false,false,false); RESC();
  { float sacc=pB0[0]+pB0[1]; _Pragma("unroll") for(int r=2;r<16;++r)sacc+=pB0[r]; _Pragma("unroll") for(int r=0;r<16;++r)sacc+=pB1[r]; l_reg+=sacc;
    pw0=(u32x4){PKW(pB0,0),PKW(pB0,2),PKW(pB0,4),PKW(pB0,6)};pw1=(u32x4){PKW(pB0,8),PKW(pB0,10),PKW(pB0,12),PKW(pB0,14)};pw2=(u32x4){PKW(pB1,0),PKW(pB1,2),PKW(pB1,4),PKW(pB1,6)};pw3=(u32x4){PKW(pB1,8),PKW(pB1,10),PKW(pB1,12),PKW(pB1,14)};
    SBAR(); pv(o,vb0+sl_cur,PAF(0),PAF(1),PAF(2),PAF(3)); }
  #undef PKW
  #undef PAF
  #undef VFR
  #undef PIN
  #undef MX3
  #undef GAPA
  #undef GAPB
  #undef EX
  #undef VRD
  #undef KRD
  #undef STEP
  #undef ENDW
  {auto rr=__builtin_amdgcn_permlane32_swap(__float_as_uint(l_reg),__float_as_uint(l_reg),false,false);l_reg=__uint_as_float(rr[0])+__uint_as_float(rr[1]);}
  if(hi==0)wsf[32+r32]=l_reg;asm volatile("s_waitcnt lgkmcnt(0)":::"memory");
  float rli[16];
  #pragma unroll
  for(int r=0;r<16;++r)rli[r]=__builtin_amdgcn_rcpf(wsf[32+crow(r,hi)]);
  bf16*Ow=O+(rowbase+q0+wid*QBLK)*OP+h*D;
  { bf16*stg=(bf16*)(shm+LDS_OST)+wid*2048;
    #pragma unroll
    for(int r=0;r<16;++r){const int orow=crow(r,hi);
      #pragma unroll
      for(int d0=0;d0<2;++d0)stg[orow*64+d0*32+r32]=__float2bfloat16(o[d0][r]*rli[r]);}
    asm volatile("s_waitcnt lgkmcnt(0)":::"memory");
    #pragma unroll
    for(int i=0;i<4;++i){const int row=i*8+(lane>>3),ch=lane&7; const u32x4 v=*(const u32x4*)(stg+row*64+ch*8); ATTN_STORE16(Ow+(long)row*OP+ch*8,v);} }
  asm volatile("s_waitcnt lgkmcnt(0)\n\ts_barrier":::"memory");
  #undef DMA_K
  #undef DMA_V
  #undef CMASK
  #undef START
  #undef RESC
  #undef ROT
}
constexpr int ATTN_LDS_BYTES=LDS_BYTES;
struct AttnTensors { const bf16* Q; const bf16* K; const bf16* V; bf16* O; };
struct AttnUnit { int b; int h; int qb; };
struct StaticOrder {
  int vcu, G;
  __device__ __forceinline__ StaticOrder(int grid,int block):vcu((grid%8==0)?(block%8)*(grid/8)+block/8:block),G(grid){}
  __device__ __forceinline__ bool next(int i,AttnUnit&u)const{ const int j=vcu+i*G; if(j>=4*NHEAD*NQB)return false; const int r=j/NQB; u.qb=j%NQB; const int bk=r%8, hl=r/8; u.b=bk/NKVH; u.h=(bk%NKVH)*(NHEAD/NKVH)+hl; return true; }
};
template<int THRL=8> __device__ __forceinline__ void attn_phase(char*lds,const AttnTensors&T,const StaticOrder&S){
  AttnUnit u;
  for(int i=0;S.next(i,u);++i){ attn_unit<THRL>(u.b,u.h,u.qb,T.Q,T.K,T.V,T.O,lds); }
}
#undef SBAR
#undef WAIT_BAR
}
#define GAS __attribute__((address_space(1)))
#define LAS __attribute__((address_space(3)))
typedef unsigned short bf16;
typedef unsigned v4u __attribute__((ext_vector_type(4)));
typedef float f32x4 __attribute__((ext_vector_type(4)));
typedef short bf16x8 __attribute__((ext_vector_type(8)));
typedef GAS unsigned gu32;
typedef GAS unsigned long long gu64;
#define RLX_AGENT __ATOMIC_RELAXED, __HIP_MEMORY_SCOPE_AGENT
#define LDS_WAIT() asm volatile("s_waitcnt lgkmcnt(0)" ::: "memory")
#define VM_WAIT() asm volatile("s_waitcnt vmcnt(0)" ::: "memory")
__device__ __forceinline__ unsigned long long rt() { return __builtin_amdgcn_s_memrealtime(); }
__device__ __forceinline__ unsigned f2bf(float f) { unsigned u = __builtin_bit_cast(unsigned, f); return (u + 0x7fffu + ((u >> 16) & 1u)) >> 16; }
__device__ __forceinline__ unsigned pk2(float lo, float hi) { return f2bf(lo) | (f2bf(hi) << 16); }

#define XB_TMO      128
#define XB_XCNT(j)  (256  + 64 * (j))
#define XB_XSUB(j)  (1280 + 64 * (j))
#define XB_XGEN(j)  (2304 + 64 * (j))
#define XB_TOP      3328
#define XB_TOPGEN   3392
#define XCD_BAR_WORDS 3456
#define XB_SPIN_CAP (1u << 18)

__device__ __forceinline__ unsigned xb_ld(unsigned* p)              { return __hip_atomic_load(p, __ATOMIC_RELAXED, __HIP_MEMORY_SCOPE_AGENT); }
__device__ __forceinline__ unsigned xb_add(unsigned* p, unsigned v) { return __hip_atomic_fetch_add(p, v, __ATOMIC_RELAXED, __HIP_MEMORY_SCOPE_AGENT); }
__device__ __forceinline__ unsigned xb_xcc_id() { return (unsigned)__builtin_amdgcn_s_getreg((3 << 11) | 20) & 0xFu; }
#define XB_SPIN(cond, bar) do { unsigned _sp = 0; while (cond) { __builtin_amdgcn_s_sleep(1); \
    if ((++_sp & 255u) == 0u) { if (xb_ld(&(bar)[XB_TMO])) break; if (_sp > XB_SPIN_CAP) { atomicAdd(&(bar)[XB_TMO], 1u); break; } } } } while (0)

struct XcdBarrier {
    unsigned* bar; unsigned x;
    volatile LAS unsigned* st;
};

__device__ __forceinline__ XcdBarrier xcd_barrier_post(unsigned* bar, volatile LAS unsigned* st) {
    XcdBarrier b; b.bar = bar; b.x = xb_xcc_id(); b.st = st;
    if (threadIdx.x == 0) (void)xb_add(&bar[XB_XCNT(b.x)], 1u);
    return b;
}
__device__ __forceinline__ void xcd_barrier_complete(unsigned* bar, unsigned x, unsigned& nloc, unsigned& nx) {
    const unsigned G = gridDim.x * gridDim.y * gridDim.z;
    unsigned sum, cnt, mine, sp = 0u;
    for (;;) {
        sum = 0u; cnt = 0u; mine = 0u;
#pragma unroll
        for (unsigned j = 0; j < 16; ++j) { const unsigned c = xb_ld(&bar[XB_XCNT(j)]); sum += c; cnt += (c > 0u) ? 1u : 0u; mine = (j == x) ? c : mine; }
        if (sum == G) break;
        __builtin_amdgcn_s_sleep(1);
        if ((++sp & 255u) == 0u) { if (xb_ld(&bar[XB_TMO])) break; if (sp > XB_SPIN_CAP) { atomicAdd(&bar[XB_TMO], 1u); break; } }
    }
    nloc = mine > 0u ? mine : 1u; nx = cnt > 0u ? cnt : 1u;
}

__device__ __forceinline__ void xcd_barrier(const XcdBarrier& b) {
    asm volatile("s_waitcnt vmcnt(0)" ::: "memory");
    __syncthreads();
    if (threadIdx.x == 0) {
        unsigned* bar = b.bar;
        __builtin_amdgcn_s_waitcnt(0);
        unsigned nloc = b.st[0], nx = b.st[1];
        if (nloc == 0u) { xcd_barrier_complete(bar, b.x, nloc, nx); b.st[0] = nloc; b.st[1] = nx; }
        const unsigned old = xb_add(&bar[XB_XSUB(b.x)], 1u);
        const unsigned gen = old / nloc;
        if (old + 1u == (gen + 1u) * nloc) {
            __builtin_amdgcn_fence(__ATOMIC_RELEASE, "agent");
            asm volatile("s_waitcnt vmcnt(0)" ::: "memory");
            const unsigned og = xb_add(&bar[XB_TOP], 1u);
            const unsigned tg = og / nx;
            if (og + 1u == (tg + 1u) * nx) xb_add(&bar[XB_TOPGEN], 1u);
            else XB_SPIN(xb_ld(&bar[XB_TOPGEN]) == tg, bar);
            __builtin_amdgcn_fence(__ATOMIC_ACQUIRE, "agent");
            xb_add(&bar[XB_XGEN(b.x)], 1u);
            asm volatile("s_waitcnt vmcnt(0)" ::: "memory");
        } else {
            XB_SPIN(xb_ld(&bar[XB_XGEN(b.x)]) == gen, bar);
            __builtin_amdgcn_fence(__ATOMIC_ACQUIRE, "agent");
            asm volatile("s_waitcnt vmcnt(0)" ::: "memory");
        }
    }
    __syncthreads();
}

constexpr int NWAVES = 8;
constexpr int DM = 1024, NBATCH = 4, SEQ = 8192, M = NBATCH * SEQ, CTXL = 256, MC = NBATCH * CTXL, MA = M + MC;
constexpr int NIN = 2304, SKV = SEQ + CTXL;
constexpr int DFF = 2816, NEXP = 8, EFF = 3584, NCHUNK = M / 128;
constexpr float EPS = 1e-6f;
constexpr int N_PHASES = 16;
#ifndef MK_PER_PHASE
#define MK_PER_PHASE 0
#endif

constexpr size_t MiB = 1u << 20, QM = 256u * 1024u;
constexpr size_t WS_CTL = 0, CTL_ZERO_BYTES = 1 * MiB;
constexpr size_t WS_MODV = 1 * MiB;
constexpr size_t WS_ROPE = 1 * MiB + QM;
constexpr size_t WS_PERM = 2 * MiB;
constexpr size_t WS_TOKSLOT = 3 * MiB, WS_TOKW = 3 * MiB + QM;
constexpr size_t WS_WIN = 16 * QM, WS_WOUT = 34 * QM, WS_WGU = 42 * QM, WS_WD = 86 * QM, WS_WGIN = 108 * QM, WS_WGOUT = 124 * QM, WS_WSB = 132 * QM;
constexpr size_t WS_WEGU = 34 * MiB, WS_WED = 90 * MiB;
constexpr size_t A0 = 118 * MiB;
constexpr size_t WS_HX = A0, WS_QKV = A0 + 66 * MiB, WS_Q = A0 + 858 * QM  , WS_KALL = A0 + 986 * QM  , WS_VALL = A0 + 1019 * QM  , WS_AC = A0 + 263 * MiB;
constexpr size_t WS_Y = A0, WS_H2 = A0 + 66 * MiB, WS_HID = A0 + 130 * MiB;
constexpr size_t WS_U = A0 + 130 * MiB, WS_VT = A0 + 194 * MiB, WS_GM = A0 + 258 * MiB;
constexpr int TMAX = 264;
constexpr size_t WS_HIDE = A0, WS_OSL = A0 + 232 * MiB, WS_H4 = A0 + 424 * MiB;
constexpr size_t WS_END = A0 + 456 * MiB;
constexpr float W_SCALE = 64.0f, H4_SCALE = 4.0f, HID_SCALE = 4.0f;
static_assert(WS_WIN + (size_t)NIN * DM * 2 <= WS_WOUT && WS_WOUT + (size_t)DM * DM * 2 <= WS_WGU && WS_WGU + (size_t)2 * DFF * DM * 2 <= WS_WD && WS_WD + (size_t)DM * DFF * 2 <= WS_WGIN &&
              WS_WGIN + (size_t)2048 * DM * 2 <= WS_WGOUT && WS_WGOUT + (size_t)DM * DM * 2 <= WS_WSB && WS_WSB + (size_t)8 * 128 * 128 * 2 <= WS_WEGU && WS_WEGU + (size_t)NEXP * 2 * EFF * DM <= WS_WED &&
              WS_WED + (size_t)NEXP * DM * EFF <= A0, "weight map");
static_assert(WS_HX + (size_t)MA * DM * 2 <= WS_QKV && WS_QKV + (size_t)MA * NIN * 2 <= WS_Q && WS_Q + (size_t)M * 512 * 2 <= WS_KALL && WS_KALL + (size_t)NBATCH * SKV * 128 * 2 <= WS_VALL &&
              WS_VALL + (size_t)NBATCH * SKV * 128 * 2 <= WS_AC && WS_AC + (size_t)M * DM * 2 <= WS_END, "layer-0 activation map");
static_assert(WS_HID + (size_t)M * DFF * 2 <= WS_END && WS_H2 + (size_t)M * DM * 2 <= WS_HID && WS_GM + (size_t)M * DM * 2 <= WS_H4 && WS_HIDE + (size_t)TMAX * 256 * EFF <= WS_OSL &&
              WS_OSL + (size_t)TMAX * 256 * DM * 2 <= WS_H4 && WS_H4 + (size_t)M * DM <= WS_END, "layer-1 activation map");
constexpr int CW_TMO = 0, CW_CODE = 1, CW_BAR = 4096, CW_CNT = 8192;

constexpr int RING_OFF = 0, RING_BYTES = 131072;
constexpr int LDSCTL_OFF = RING_BYTES, MISC_OFF = LDSCTL_OFF + 320;
constexpr int MOE_OFF = LDSCTL_OFF + 512;
constexpr int IDX_OFF = LDSCTL_OFF + 2048, IDX_UNITS = 8;
constexpr int LDS_BYTES = 147456;
static_assert(MOE_OFF + (32 + 272) * 4 <= IDX_OFF && IDX_OFF + 8 * 256 * 4 <= LDS_BYTES, "LDS map");

struct Frame {
    LAS unsigned char* lds;
    volatile LAS unsigned* MISC;
    gu32* ctl;
    int tid, lane, wave;
    int vcu, G;
};
struct Args { const float* in[35]; float* out; unsigned char* ws; int ph_lo, ph_hi; };

__device__ __forceinline__ float wave_sum(float v) {
#pragma unroll
    for (int o = 1; o < 64; o <<= 1) v += __shfl_xor(v, o);
    return v;
}
__device__ __forceinline__ float bf_lo(unsigned u) { return __uint_as_float(u << 16); }
__device__ __forceinline__ float bf_hi(unsigned u) { return __uint_as_float(u & 0xffff0000u); }
__device__ __forceinline__ float sq4(const f32x4 v) { return (v.x * v.x + v.y * v.y) + (v.z * v.z + v.w * v.w); }
typedef unsigned u32x2 __attribute__((ext_vector_type(2)));
__device__ __forceinline__ void ld_row_f32(const float* row, int lane, f32x4 (&v)[4]) { const GAS f32x4* p = (const GAS f32x4*)row + lane;
#pragma unroll
    for (int j = 0; j < 4; ++j) v[j] = p[64 * j]; }
__device__ __forceinline__ void st_row_f32(float* row, int lane, const f32x4 (&v)[4]) { GAS f32x4* p = (GAS f32x4*)row + lane;
#pragma unroll
    for (int j = 0; j < 4; ++j) p[64 * j] = v[j]; }
__device__ __forceinline__ void ld_row_bf16(const bf16* row, int lane, f32x4 (&v)[4]) { const GAS u32x2* p = (const GAS u32x2*)row + lane;
#pragma unroll
    for (int j = 0; j < 4; ++j) { const u32x2 w = p[64 * j]; v[j] = (f32x4){bf_lo(w.x), bf_hi(w.x), bf_lo(w.y), bf_hi(w.y)}; } }
__device__ __forceinline__ void st_row_bf16(bf16* row, int lane, const f32x4 (&v)[4]) { GAS u32x2* p = (GAS u32x2*)row + lane;
#pragma unroll
    for (int j = 0; j < 4; ++j) { u32x2 w; w.x = pk2(v[j].x, v[j].y); w.y = pk2(v[j].z, v[j].w); p[64 * j] = w; } }
__device__ __forceinline__ void unpack8(const v4u w, float (&f)[8]) { f[0] = bf_lo(w.x); f[1] = bf_hi(w.x); f[2] = bf_lo(w.y); f[3] = bf_hi(w.y); f[4] = bf_lo(w.z); f[5] = bf_hi(w.z); f[6] = bf_lo(w.w); f[7] = bf_hi(w.w); }
__device__ __forceinline__ v4u pack8(const float (&f)[8]) { v4u w; w.x = pk2(f[0], f[1]); w.y = pk2(f[2], f[3]); w.z = pk2(f[4], f[5]); w.w = pk2(f[6], f[7]); return w; }
__device__ __forceinline__ const float* modp(const float* modv, int layer, int j, int chunk) { return modv + ((size_t)(layer * 5 + j) * 6 + chunk) * DM; }

__device__ __forceinline__ void tr_item(const float* W, int K, int N, bf16* WT, int kb, int nb, int drow0, LAS float* scr, int lane) {
    const int k0 = 64 * kb, n0 = 32 * nb;
#pragma unroll 8
    for (int i = 0; i < 32; ++i) { const int kk = 2 * i + (lane >> 5); scr[kk * 33 + (lane & 31)] = W[(size_t)(k0 + kk) * N + n0 + (lane & 31)]; }
    LDS_WAIT(); asm volatile("" ::: "memory");
    const int c = lane & 7;
#pragma unroll
    for (int j = 0; j < 4; ++j) { const int n = (lane >> 3) + 8 * j; const LAS float* s = scr + (8 * c) * 33 + n;
        v4u o; o.x = pk2(s[0 * 33], s[1 * 33]); o.y = pk2(s[2 * 33], s[3 * 33]); o.z = pk2(s[4 * 33], s[5 * 33]); o.w = pk2(s[6 * 33], s[7 * 33]);
        *(GAS v4u*)(WT + (size_t)(drow0 + n) * K + k0 + 8 * c) = o; }
    LDS_WAIT(); asm volatile("" ::: "memory");
}
__device__ __forceinline__ void tr_item8(const float* W, int K, int N, unsigned char* WT, int kb, int nb, int drow0, float sc, LAS float* scr, int lane) {
    const int k0 = 64 * kb, n0 = 32 * nb;
#pragma unroll 8
    for (int i = 0; i < 32; ++i) { const int kk = 2 * i + (lane >> 5); scr[kk * 33 + (lane & 31)] = W[(size_t)(k0 + kk) * N + n0 + (lane & 31)]; }
    LDS_WAIT(); asm volatile("" ::: "memory");
    const int c = lane & 7;
#pragma unroll
    for (int j = 0; j < 4; ++j) { const int n = (lane >> 3) + 8 * j; const LAS float* s = scr + (8 * c) * 33 + n;
        u32x2 o; o.x = pg8::pack4_fp8(s[0 * 33] * sc, s[1 * 33] * sc, s[2 * 33] * sc, s[3 * 33] * sc); o.y = pg8::pack4_fp8(s[4 * 33] * sc, s[5 * 33] * sc, s[6 * 33] * sc, s[7 * 33] * sc);
        *(GAS u32x2*)(WT + (size_t)(drow0 + n) * K + k0 + 8 * c) = o; }
    LDS_WAIT(); asm volatile("" ::: "memory");
}
__device__ __forceinline__ int swiglu_row(int n0) { return 256 * (n0 >> 7) + (n0 & 127); }
__device__ __forceinline__ void sincos_small(float a, float& s, float& c) {
    const float kf = rintf(a * 0.636619772f); const int k = (int)kf;
    float r = fmaf(-kf, 1.5707962513e+00f, a); r = fmaf(-kf, 7.5497894159e-08f, r); r = fmaf(-kf, 5.3903029534e-15f, r);
    const float r2 = r * r;
    const float sp = r + r * r2 * (-1.6666654611e-1f + r2 * (8.3321608736e-3f + r2 * (-1.9515295891e-4f)));
    const float cp = 1.0f - 0.5f * r2 + r2 * r2 * (4.166664568298827e-2f + r2 * (-1.388731625493765e-3f + r2 * 2.443315711809948e-5f));
    const int q = k & 3;
    s = (q == 0) ? sp : (q == 1) ? cp : (q == 2) ? -sp : -cp;
    c = (q == 0) ? cp : (q == 1) ? -sp : (q == 2) ? -cp : sp;
}
__device__ __forceinline__ void p0_mod_item(Frame& F, const float* W, const float* bias, const float* c, const float* cctx, float* modv_layer, int cb) {
    const int col0 = cb * 256; LAS float* red = (LAS float*)F.lds;
    f32x4 acc[5];
#pragma unroll
    for (int j = 0; j < 5; ++j) acc[j] = (f32x4){0.f, 0.f, 0.f, 0.f};
    const int k0 = F.wave * 128;
#pragma unroll 4
    for (int k = k0; k < k0 + 128; ++k) {
        const f32x4 wv = *(const GAS f32x4*)(W + (size_t)k * 6144 + col0 + 4 * F.lane);
#pragma unroll
        for (int j = 0; j < 5; ++j) { const float cj = (j < 4) ? c[j * DM + k] : cctx[k]; const float s = cj / (1.0f + __expf(-cj)); acc[j] += wv * s; }
    }
#pragma unroll
    for (int j = 0; j < 5; ++j) *(LAS f32x4*)(red + ((F.wave * 5 + j) * 256 + 4 * F.lane)) = acc[j];
    __syncthreads();
    for (int o = F.tid; o < 5 * 256; o += NWAVES * 64) { const int j = o >> 8, cc = o & 255; float s = bias[col0 + cc];
#pragma unroll
        for (int w = 0; w < 8; ++w) s += red[(w * 5 + j) * 256 + cc];
        modv_layer[(size_t)j * 6144 + col0 + cc] = s; }
    __syncthreads();
}
__device__ __forceinline__ void p0_prologue(Frame& F, const Args& a) {
    unsigned char* ws = a.ws;
    float* modv = (float*)(ws + WS_MODV);
    for (int it = blockIdx.x; it < 48; it += F.G) { const int layer = it / 24, cb = it % 24;
        p0_mod_item(F, layer ? a.in[18] : a.in[4], layer ? a.in[19] : a.in[5], a.in[1], a.in[3], modv + (size_t)layer * 5 * 6144, cb); }
    const int gt = blockIdx.x * (NWAVES * 64) + F.tid, NGT = F.G * NWAVES * 64;
    { float* tab = (float*)(ws + WS_ROPE);
      for (int i = gt; i < 192 * 16; i += NGT) { const int p = i >> 4, k = i & 15; const float pos = (float)(p < 128 ? p : p - 128);
          const float inv = 1.0f / powf(10000.0f, (float)(2 * k) / 32.0f); float s, c; sincos_small(pos * inv, s, c); tab[2 * i] = c; tab[2 * i + 1] = s; } }
    { const float* wsf = a.in[25]; bf16* wsb = (bf16*)(ws + WS_WSB);
      for (int i = gt; i < 8 * 128 * 128 / 4; i += NGT) { const f32x4 v = *(const GAS f32x4*)(wsf + 4 * (size_t)i); u32x2 w; w.x = pk2(v.x, v.y); w.y = pk2(v.z, v.w); *(GAS u32x2*)(wsb + 4 * (size_t)i) = w; } }
    LAS float* scr = (LAS float*)(F.lds + RING_OFF + F.wave * 16384);
    const int gw = F.vcu * NWAVES + F.wave, NGW = F.G * NWAVES;
    constexpr int I_WIN = 16 * 72, I_WOUT = 16 * 32, I_FG = 16 * 88, I_FD = 44 * 32, I_GIN = 16 * 64, I_GOUT = 16 * 32, I_EG = 16 * 112, I_ED = 56 * 32;
    constexpr int NITEMS = I_WIN + I_WOUT + 2 * I_FG + I_FD + I_GIN + I_GOUT + NEXP * (2 * I_EG + I_ED);
    for (int it = gw; it < NITEMS; it += NGW) {
        int r = it;
        if (r < I_WIN) { tr_item(a.in[8], DM, NIN, (bf16*)(ws + WS_WIN), r / 72, r % 72, 32 * (r % 72), scr, F.lane); continue; } r -= I_WIN;
        if (r < I_WOUT) { tr_item(a.in[12], DM, DM, (bf16*)(ws + WS_WOUT), r / 32, r % 32, 32 * (r % 32), scr, F.lane); continue; } r -= I_WOUT;
        if (r < I_FG) { tr_item(a.in[15], DM, DFF, (bf16*)(ws + WS_WGU), r / 88, r % 88, swiglu_row(32 * (r % 88)), scr, F.lane); continue; } r -= I_FG;
        if (r < I_FG) { tr_item(a.in[16], DM, DFF, (bf16*)(ws + WS_WGU), r / 88, r % 88, swiglu_row(32 * (r % 88)) + 128, scr, F.lane); continue; } r -= I_FG;
        if (r < I_FD) { tr_item(a.in[17], DFF, DM, (bf16*)(ws + WS_WD), r / 32, r % 32, 32 * (r % 32), scr, F.lane); continue; } r -= I_FD;
        if (r < I_GIN) { tr_item(a.in[22], DM, 2048, (bf16*)(ws + WS_WGIN), r / 64, r % 64, 32 * (r % 64), scr, F.lane); continue; } r -= I_GIN;
        if (r < I_GOUT) { tr_item(a.in[27], DM, DM, (bf16*)(ws + WS_WGOUT), r / 32, r % 32, 32 * (r % 32), scr, F.lane); continue; } r -= I_GOUT;
        if (r < NEXP * I_EG) { const int e = r / I_EG, q = r % I_EG; tr_item8(a.in[32] + (size_t)e * DM * EFF, DM, EFF, ws + WS_WEGU, q / 112, q % 112, e * 2 * EFF + swiglu_row(32 * (q % 112)), W_SCALE, scr, F.lane); continue; } r -= NEXP * I_EG;
        if (r < NEXP * I_EG) { const int e = r / I_EG, q = r % I_EG; tr_item8(a.in[33] + (size_t)e * DM * EFF, DM, EFF, ws + WS_WEGU, q / 112, q % 112, e * 2 * EFF + swiglu_row(32 * (q % 112)) + 128, W_SCALE, scr, F.lane); continue; } r -= NEXP * I_EG;
        { const int e = r / I_ED, q = r % I_ED; tr_item8(a.in[34] + (size_t)e * EFF * DM, EFF, DM, ws + WS_WED, q / 32, q % 32, e * DM + 32 * (q % 32), W_SCALE, scr, F.lane); }
    }
}

__device__ __forceinline__ void prenorm_rows16(const float* src, bf16* dst, int lane, const f32x4 (&aa)[4], const f32x4 (&sh)[4], int nrows) {
    for (int i = 0; i < nrows; ++i) {
        f32x4 v[4]; ld_row_f32(src + (size_t)i * DM, lane, v);
        const float ss = wave_sum((sq4(v[0]) + sq4(v[1])) + (sq4(v[2]) + sq4(v[3])));
        const float rstd = rsqrtf(ss * (1.0f / DM) + EPS);
#pragma unroll
        for (int j = 0; j < 4; ++j) v[j] = v[j] * rstd * aa[j] + sh[j];
        st_row_bf16(dst + (size_t)i * DM, lane, v);
    }
}
__device__ __forceinline__ void load_pre_vecs(const float* modv, int layer, int j, int ch_shift, int ch_scale, const float* g, int lane, f32x4 (&aa)[4], f32x4 (&sh)[4]) {
    f32x4 sc[4], gg[4]; ld_row_f32(modp(modv, layer, j, ch_scale), lane, sc); ld_row_f32(g, lane, gg); ld_row_f32(modp(modv, layer, j, ch_shift), lane, sh);
#pragma unroll
    for (int k = 0; k < 4; ++k) aa[k] = gg[k] * (sc[k] + 1.0f);
}
__device__ __forceinline__ void p1_prenorm(Frame& F, const Args& a) {
    const float* modv = (const float*)(a.ws + WS_MODV); bf16* HX = (bf16*)(a.ws + WS_HX);
    const int gw = F.vcu * NWAVES + F.wave, NGW = F.G * NWAVES;
    for (int blk = gw; blk < M / 16; blk += NGW) { const int m0 = blk * 16, b = m0 / SEQ;
        f32x4 aa[4], sh[4]; load_pre_vecs(modv, 0, b, 0, 1, a.in[6], F.lane, aa, sh);
        prenorm_rows16(a.in[0] + (size_t)m0 * DM, HX + (size_t)m0 * DM, F.lane, aa, sh, 16); }
    for (int blk = gw; blk < MC / 16; blk += NGW) { const int m0 = blk * 16;
        f32x4 aa[4], sh[4]; load_pre_vecs(modv, 0, 4, 0, 1, a.in[6], F.lane, aa, sh);
        prenorm_rows16(a.in[2] + (size_t)m0 * DM, HX + (size_t)(M + m0) * DM, F.lane, aa, sh, 16); }
}

constexpr float ATT_C2 = 0.125f * 1.4426950408889634f;
__device__ __forceinline__ void norm_rope8(float (&x)[8], const float (&g)[8], int lane, bool do_rope, const float* tab_lo  , float outscale) {
    float ss = 0.f;
#pragma unroll
    for (int e = 0; e < 8; ++e) ss += x[e] * x[e];
    ss += __shfl_xor(ss, 1); ss += __shfl_xor(ss, 2); ss += __shfl_xor(ss, 4);
    const float rstd = rsqrtf(ss * (1.0f / 64.0f) + EPS);
#pragma unroll
    for (int e = 0; e < 8; ++e) x[e] = x[e] * rstd * g[e];
    float p[8];
#pragma unroll
    for (int e = 0; e < 8; ++e) p[e] = __shfl_xor(x[e], 4);
    if (do_rope) {
        const bool upper = (lane & 4) != 0;
#pragma unroll
        for (int e = 0; e < 8; ++e) { const float cs = tab_lo[2 * e], sn = tab_lo[2 * e + 1]; x[e] = upper ? (x[e] * cs + p[e] * sn) : (x[e] * cs - p[e] * sn); }
    }
#pragma unroll
    for (int e = 0; e < 8; ++e) x[e] *= outscale;
}
__device__ __forceinline__ void p3_qkv_post(Frame& F, const Args& a) {
    unsigned char* ws = a.ws;
    const bf16* QKV = (const bf16*)(ws + WS_QKV); bf16* Q = (bf16*)(ws + WS_Q); bf16* KALL = (bf16*)(ws + WS_KALL); bf16* VALL = (bf16*)(ws + WS_VALL); bf16* AC = (bf16*)(ws + WS_AC);
    const float* tab = (const float*)(ws + WS_ROPE); const float* gq = a.in[9]; const float* gk = a.in[10]; const float* wconv = a.in[11];
    const int lane = F.lane, gw = F.vcu * NWAVES + F.wave, NGW = F.G * NWAVES;
    const int d0 = 8 * (lane & 7);
    float gq8[8], gk8[8], w0[8], w1[8], w2[8];
#pragma unroll
    for (int e = 0; e < 8; ++e) { gq8[e] = gq[d0 + e]; gk8[e] = gk[d0 + e]; w0[e] = wconv[8 * lane + e]; w1[e] = wconv[512 + 8 * lane + e]; w2[e] = wconv[1024 + 8 * lane + e]; }
    const int pi0 = 8 * (lane & 3);
    for (int m = gw; m < MA; m += NGW) {
        const bf16* row = QKV + (size_t)m * NIN;
        if (m < M) {
            const int b = m / SEQ, t = m % SEQ, gr = t >> 6, gc = t & 63;
            const float* tl = tab + 2 * (size_t)((pi0 < 16 ? gr : 128 + gc) * 16 + (pi0 & 15));
            { float x[8]; unpack8(*(const GAS v4u*)(row + 8 * lane), x); norm_rope8(x, gq8, lane, true, tl, ATT_C2); *(GAS v4u*)(Q + (size_t)m * 512 + 8 * lane) = pack8(x); }
            { float x[8]; v4u kw = (v4u){0u, 0u, 0u, 0u}; if (lane < 16) kw = *(const GAS v4u*)(row + 512 + 8 * lane); unpack8(kw, x); norm_rope8(x, gk8, lane, true, tl, 1.0f);
              const size_t kvrow = (size_t)b * SKV + CTXL + t;
              if (lane < 16) { *(GAS v4u*)(KALL + kvrow * 128 + 8 * lane) = pack8(x); *(GAS v4u*)(VALL + kvrow * 128 + 8 * lane) = *(const GAS v4u*)(row + 640 + 8 * lane); } }
            { float Bg[8], c0[8], h0[8], z[8], zp[8], zn[8];
              unpack8(*(const GAS v4u*)(row + 768 + 8 * lane), Bg); unpack8(*(const GAS v4u*)(row + 1280 + 8 * lane), c0); unpack8(*(const GAS v4u*)(row + 1792 + 8 * lane), h0);
#pragma unroll
              for (int e = 0; e < 8; ++e) { z[e] = c0[e] * h0[e]; zp[e] = 0.f; zn[e] = 0.f; }
              if (t > 0) { float c1[8], h1[8]; unpack8(*(const GAS v4u*)(row - NIN + 1280 + 8 * lane), c1); unpack8(*(const GAS v4u*)(row - NIN + 1792 + 8 * lane), h1);
#pragma unroll
                  for (int e = 0; e < 8; ++e) zp[e] = c1[e] * h1[e]; }
              if (t < SEQ - 1) { float c1[8], h1[8]; unpack8(*(const GAS v4u*)(row + NIN + 1280 + 8 * lane), c1); unpack8(*(const GAS v4u*)(row + NIN + 1792 + 8 * lane), h1);
#pragma unroll
                  for (int e = 0; e < 8; ++e) zn[e] = c1[e] * h1[e]; }
              float o[8];
#pragma unroll
              for (int e = 0; e < 8; ++e) o[e] = Bg[e] * (w0[e] * zp[e] + w1[e] * z[e] + w2[e] * zn[e]);
              *(GAS v4u*)(AC + (size_t)m * DM + 512 + 8 * lane) = pack8(o); }
        } else {
            const int j = m - M, b = j / CTXL, jj = j % CTXL;
            float x[8]; v4u kw = (v4u){0u, 0u, 0u, 0u}; if (lane < 16) kw = *(const GAS v4u*)(row + 512 + 8 * lane); unpack8(kw, x); norm_rope8(x, gk8, lane, false, tab, 1.0f);
            const size_t kvrow = (size_t)b * SKV + jj;
            if (lane < 16) { *(GAS v4u*)(KALL + kvrow * 128 + 8 * lane) = pack8(x); *(GAS v4u*)(VALL + kvrow * 128 + 8 * lane) = *(const GAS v4u*)(row + 640 + 8 * lane); }
        }
    }
}

template <bool ROUTE>
__device__ __forceinline__ void rows_update(Frame& F, const Args& a, const float* xin, const bf16* Y, int layer, int ch_gate, const float* gpost, int nlayer, int ch_shift, int ch_scale, const float* gpre, bf16* H) {
    const float* modv = (const float*)(a.ws + WS_MODV); float* xout = a.out;
    const int lane = F.lane, gw = F.vcu * NWAVES + F.wave, NGW = F.G * NWAVES;
    LAS float* wrl = (LAS float*)(F.lds + RING_OFF);
    if (ROUTE) { const float* wr = a.in[30]; for (int i = F.tid; i < DM * NEXP / 4; i += NWAVES * 64) *(LAS f32x4*)(wrl + 4 * i) = *(const GAS f32x4*)(wr + 4 * i); __syncthreads(); }
    for (int blk = gw; blk < M / 16; blk += NGW) { const int m0 = blk * 16, b = m0 / SEQ;
        f32x4 gg[4], aa[4], sh[4];
        { f32x4 gt[4], gp[4]; ld_row_f32(modp(modv, layer, b, ch_gate), lane, gt); ld_row_f32(gpost, lane, gp);
#pragma unroll
          for (int k = 0; k < 4; ++k) gg[k] = gt[k] * gp[k]; }
        load_pre_vecs(modv, nlayer, b, ch_shift, ch_scale, gpre, lane, aa, sh);
        int me0 = 0, me1 = 0; float mw0 = 0.f, mw1 = 0.f;
        for (int i = 0; i < 16; ++i) { const size_t m = (size_t)(m0 + i);
            f32x4 x[4], y[4]; ld_row_f32(xin + m * DM, lane, x); ld_row_bf16(Y + m * DM, lane, y);
            const float ssy = wave_sum((sq4(y[0]) + sq4(y[1])) + (sq4(y[2]) + sq4(y[3])));
            const float ry = rsqrtf(ssy * (1.0f / DM) + EPS);
#pragma unroll
            for (int j = 0; j < 4; ++j) x[j] = x[j] + gg[j] * (y[j] * ry);
            st_row_f32(xout + m * DM, lane, x);
            const float ssx = wave_sum((sq4(x[0]) + sq4(x[1])) + (sq4(x[2]) + sq4(x[3])));
            const float rx = rsqrtf(ssx * (1.0f / DM) + EPS);
#pragma unroll
            for (int j = 0; j < 4; ++j) x[j] = x[j] * rx * aa[j] + sh[j];
            if (ROUTE) {
                GAS unsigned* hp = (GAS unsigned*)((unsigned char*)H + m * DM) + lane;
#pragma unroll
                for (int j = 0; j < 4; ++j) hp[64 * j] = pg8::pack4_fp8(x[j].x * H4_SCALE, x[j].y * H4_SCALE, x[j].z * H4_SCALE, x[j].w * H4_SCALE);
            } else st_row_bf16(H + m * DM, lane, x);
            if (ROUTE) {
                float lg[8];
#pragma unroll
                for (int e = 0; e < 8; ++e) lg[e] = 0.f;
#pragma unroll
                for (int j = 0; j < 4; ++j)
#pragma unroll
                    for (int q = 0; q < 4; ++q) { const LAS float* wp = wrl + (256 * j + 4 * lane + q) * 8; const f32x4 wa = *(const LAS f32x4*)wp, wb = *(const LAS f32x4*)(wp + 4); const float hv = x[j][q];
                        lg[0] += hv * wa.x; lg[1] += hv * wa.y; lg[2] += hv * wa.z; lg[3] += hv * wa.w; lg[4] += hv * wb.x; lg[5] += hv * wb.y; lg[6] += hv * wb.z; lg[7] += hv * wb.w; }
                const float* br = a.in[31];
#pragma unroll
                for (int e = 0; e < 8; ++e) lg[e] = wave_sum(lg[e]) + br[e];
                int e0 = 0; float l0 = lg[0];
#pragma unroll
                for (int e = 1; e < 8; ++e) if (lg[e] > l0) { l0 = lg[e]; e0 = e; }
                int e1 = -1; float l1 = -INFINITY;
#pragma unroll
                for (int e = 0; e < 8; ++e) if (e != e0 && lg[e] > l1) { l1 = lg[e]; e1 = e; }
                const float w0 = 1.0f / (1.0f + __expf(l1 - l0));
                if (lane == i) { me0 = e0; me1 = e1; mw0 = w0; mw1 = 1.0f - w0; }
            }
        }
        if (ROUTE) {
            gu32* cnt = F.ctl + CW_CNT; int* perm = (int*)(a.ws + WS_PERM); int* tokslot = (int*)(a.ws + WS_TOKSLOT); float* tokw = (float*)(a.ws + WS_TOKW);
#pragma unroll 1
            for (int e = 0; e < NEXP; ++e) {
                const bool has = (lane < 16) && (me0 == e || me1 == e);
                const unsigned long long mask = __ballot(has); const int n = __popcll(mask);
                if (n) { unsigned base = 0u; if (lane == 0) base = __hip_atomic_fetch_add(cnt + 64 * e, (unsigned)n, RLX_AGENT); base = (unsigned)__shfl((int)base, 0);
                    if (has) { const int rank = (int)base + __popcll(mask & ((1ull << lane) - 1ull)); const int k = (me0 == e) ? 0 : 1; const int tok = m0 + lane;
                        perm[(size_t)e * M + rank] = tok; tokslot[2 * tok + k] = e * 32768 + rank; tokw[2 * tok + k] = k ? mw1 : mw0; } }
            }
        }
    }
    if (ROUTE) __syncthreads();
}

__device__ __forceinline__ void p11_spatial(Frame& F, const Args& a) {
    typedef float f32x16 __attribute__((ext_vector_type(16))); typedef float f32x2v __attribute__((ext_vector_type(2)));
    unsigned char* ws = a.ws;
    const bf16* VT = (const bf16*)(ws + WS_VT); const bf16* U = (const bf16*)(ws + WS_U); const bf16* WSB = (const bf16*)(ws + WS_WSB); bf16* GM = (bf16*)(ws + WS_GM);
    const float* gv = a.in[23]; const float* bv = a.in[24]; const float* bs = a.in[26];
    const int lane = F.lane, g = F.wave, l32 = lane & 31, hi = lane >> 5;
    LAS f32x2v* part = (LAS f32x2v*)(F.lds + RING_OFF);
    LAS f32x2v* stat = (LAS f32x2v*)(F.lds + RING_OFF + 8192);
    for (int ch = F.vcu; ch < NCHUNK; ch += F.G) {
        const bf16* vt = VT + (size_t)ch * DM * 128;
        { float s[8], q[8];
#pragma unroll
          for (int e = 0; e < 8; ++e) { s[e] = 0.f; q[e] = 0.f; }
#pragma unroll 4
          for (int it = 0; it < 32; ++it) { const int c = 128 * g + 4 * it + (lane >> 4); float v[8]; unpack8(*(const GAS v4u*)(vt + (size_t)c * 128 + 8 * (lane & 15)), v);
#pragma unroll
              for (int e = 0; e < 8; ++e) { s[e] += v[e]; q[e] += v[e] * v[e]; } }
#pragma unroll
          for (int e = 0; e < 8; ++e) { s[e] += __shfl_xor(s[e], 16); s[e] += __shfl_xor(s[e], 32); q[e] += __shfl_xor(q[e], 16); q[e] += __shfl_xor(q[e], 32); }
          if (lane < 16) {
#pragma unroll
              for (int e = 0; e < 8; ++e) part[g * 128 + 8 * lane + e] = (f32x2v){s[e], q[e]}; } }
        __syncthreads();
        if (F.tid < 128) { float s = 0.f, q = 0.f;
#pragma unroll
            for (int w = 0; w < 8; ++w) { const f32x2v p = part[w * 128 + F.tid]; s += p.x; q += p.y; }
            const float mu = s * (1.0f / DM); const float var = fmaxf(q * (1.0f / DM) - mu * mu, 0.f); stat[F.tid] = (f32x2v){mu, rsqrtf(var + EPS)}; }
        __syncthreads();
        const bf16* wg = WSB + (size_t)g * 128 * 128;
#pragma unroll 1
        for (int nt = 0; nt < 4; ++nt) {
            f32x16 acc[4];
#pragma unroll
            for (int mt = 0; mt < 4; ++mt)
#pragma unroll
                for (int r = 0; r < 16; ++r) acc[mt][r] = 0.f;
            const int c = 128 * g + 32 * nt + l32; const float gvc = gv[c], bvc = bv[c];
            const bf16* vc = vt + (size_t)c * 128 + 8 * hi; const bf16* wl = wg + (size_t)l32 * 128 + 8 * hi;
            bf16x8 afn[4]; v4u vn;
#pragma unroll
            for (int mt = 0; mt < 4; ++mt) afn[mt] = *(const GAS bf16x8*)(wl + (size_t)mt * 32 * 128);
            vn = *(const GAS v4u*)vc;
#pragma unroll 1
            for (int ks = 0; ks < 8; ++ks) {
                bf16x8 af[4]; const v4u vr = vn;
#pragma unroll
                for (int mt = 0; mt < 4; ++mt) af[mt] = afn[mt];
                if (ks < 7) {
#pragma unroll
                    for (int mt = 0; mt < 4; ++mt) afn[mt] = *(const GAS bf16x8*)(wl + (size_t)mt * 32 * 128 + 16 * (ks + 1));
                    vn = *(const GAS v4u*)(vc + 16 * (ks + 1)); }
                const int q0 = 16 * ks + 8 * hi;
                float v[8]; unpack8(vr, v);
#pragma unroll
                for (int e = 0; e < 8; ++e) { const f32x2v st = stat[q0 + e]; v[e] = (v[e] - st.x) * st.y * gvc + bvc; }
                const v4u pk = pack8(v); const bf16x8 bfr = __builtin_bit_cast(bf16x8, pk);
#pragma unroll
                for (int mt = 0; mt < 4; ++mt) acc[mt] = __builtin_amdgcn_mfma_f32_32x32x16_bf16(bfr, af[mt], acc[mt], 0, 0, 0);
            }
            u32x2 uu[4][4]; float bsv[4];
#pragma unroll
            for (int mt = 0; mt < 4; ++mt) { const int p = 32 * mt + l32; bsv[mt] = bs[g * 128 + p]; const bf16* up = U + ((size_t)ch * 128 + p) * DM + 128 * g + 32 * nt + 4 * hi;
#pragma unroll
                for (int rr = 0; rr < 4; ++rr) uu[mt][rr] = *(const GAS u32x2*)(up + 8 * rr); }
#pragma unroll
            for (int mt = 0; mt < 4; ++mt) { const int p = 32 * mt + l32; bf16* gp = GM + ((size_t)ch * 128 + p) * DM + 128 * g + 32 * nt + 4 * hi;
#pragma unroll
                for (int rr = 0; rr < 4; ++rr) { const u32x2 w = uu[mt][rr]; u32x2 o;
                    o.x = pk2(bf_lo(w.x) * (acc[mt][4 * rr + 0] + bsv[mt]), bf_hi(w.x) * (acc[mt][4 * rr + 1] + bsv[mt]));
                    o.y = pk2(bf_lo(w.y) * (acc[mt][4 * rr + 2] + bsv[mt]), bf_hi(w.y) * (acc[mt][4 * rr + 3] + bsv[mt]));
                    *(GAS u32x2*)(gp + 8 * rr) = o; } }
        }
        __syncthreads();
    }
}

__device__ __forceinline__ void moe_tables(Frame& F) {
    LAS int* mt = (LAS int*)(F.lds + MOE_OFF);
    if (F.tid < NEXP) mt[F.tid] = (int)__hip_atomic_load(F.ctl + CW_CNT + 64 * F.tid, RLX_AGENT);
    __syncthreads();
    if (F.tid == 0) { int off = 0;
        for (int e = 0; e < NEXP; ++e) { mt[8 + e] = off; const int n = (mt[e] + 255) >> 8; for (int t = 0; t < n && off + t < 272; ++t) mt[32 + off + t] = e; off += n; }
        mt[16] = off; mt[24] = off < 272 ? off : 272; }
    __syncthreads();
}
__device__ __forceinline__ void p15_final(Frame& F, const Args& a) {
    const float* modv = (const float*)(a.ws + WS_MODV); const bf16* OSL = (const bf16*)(a.ws + WS_OSL); const int* tokslot = (const int*)(a.ws + WS_TOKSLOT); const float* tokw = (const float*)(a.ws + WS_TOKW);
    const LAS int* mt = (const LAS int*)(F.lds + MOE_OFF);
    const int lane = F.lane, gw = F.vcu * NWAVES + F.wave, NGW = F.G * NWAVES;
    for (int blk = gw; blk < M / 16; blk += NGW) { const int m0 = blk * 16, b = m0 / SEQ;
        f32x4 gg[4];
        { f32x4 gt[4], gp[4]; ld_row_f32(modp(modv, 1, b, 5), lane, gt); ld_row_f32(a.in[29], lane, gp);
#pragma unroll
          for (int k = 0; k < 4; ++k) gg[k] = gt[k] * gp[k]; }
        for (int i = 0; i < 16; ++i) { const size_t m = (size_t)(m0 + i);
            const int s0 = tokslot[2 * m], s1 = tokslot[2 * m + 1]; const float w0 = tokw[2 * m], w1 = tokw[2 * m + 1];
            const size_t r0 = (size_t)mt[8 + (s0 >> 15)] * 256 + (s0 & 32767), r1 = (size_t)mt[8 + (s1 >> 15)] * 256 + (s1 & 32767);
            f32x4 x[4], f0[4], f1[4]; ld_row_f32(a.out + m * DM, lane, x); ld_row_bf16(OSL + r0 * DM, lane, f0); ld_row_bf16(OSL + r1 * DM, lane, f1);
#pragma unroll
            for (int j = 0; j < 4; ++j) f0[j] = f0[j] * w0 + f1[j] * w1;
            const float ss = wave_sum((sq4(f0[0]) + sq4(f0[1])) + (sq4(f0[2]) + sq4(f0[3])));
            const float rf = rsqrtf(ss * (1.0f / DM) + EPS);
#pragma unroll
            for (int j = 0; j < 4; ++j) x[j] = x[j] + gg[j] * (f0[j] * rf);
            st_row_f32(a.out + m * DM, lane, x);
        }
    }
}

__global__ void __launch_bounds__(NWAVES * 64, 2) mk_fwd(Args args) {
    extern __shared__ __attribute__((aligned(16))) unsigned char lds[];
    Frame F;
    F.lds = (LAS unsigned char*)lds;
    F.MISC = (volatile LAS unsigned*)(F.lds + MISC_OFF);
    F.tid = threadIdx.x; F.lane = F.tid & 63; F.wave = __builtin_amdgcn_readfirstlane(F.tid >> 6);
    F.G = gridDim.x; { const int bx = blockIdx.x; F.vcu = (F.G % 8 == 0) ? (bx % 8) * (F.G / 8) + bx / 8 : bx; }
    unsigned char* ws = args.ws;
    F.ctl = (gu32*)(ws + WS_CTL);
    for (int u = F.tid; u < (LDS_BYTES - LDSCTL_OFF) / 4; u += NWAVES * 64) ((LAS unsigned*)(F.lds + LDSCTL_OFF))[u] = 0u;
    __syncthreads();
    const int lo = args.ph_lo, hi = args.ph_hi;
    XcdBarrier bar; bar.bar = (unsigned*)(F.ctl + CW_BAR); bar.x = 0; bar.st = nullptr;
    if (hi - lo > 1 || (lo <= 14 && 14 < hi)) bar = xcd_barrier_post((unsigned*)(F.ctl + CW_BAR), F.MISC + 8);
#ifndef PH_MASK
#define PH_MASK 0xFFFF
#endif
#define IN(k) ((((PH_MASK) >> (k)) & 1) && lo <= (k) && (k) < hi)
#define BOTH(k) (IN(k) && IN((k) + 1))
#define GRID_BAR() xcd_barrier(bar)
    PG8_LAS unsigned char* ring = F.lds + RING_OFF;
    const int cb = (int)blockIdx.x;
#ifndef REPEAT_PHASE
#define REPEAT_PHASE (-1)
#endif
#define NREP(k) ((REPEAT_PHASE == (k)) ? 2 : 1)

    if (IN(0)) for (int rep = 0; rep < NREP(0); ++rep) { p0_prologue(F, args); if (BOTH(0) || rep + 1 < NREP(0)) GRID_BAR(); }
    if (IN(1)) for (int rep = 0; rep < NREP(1); ++rep) { p1_prenorm(F, args); if (BOTH(1) || rep + 1 < NREP(1)) GRID_BAR(); }
    if (IN(2)) for (int rep = 0; rep < NREP(2); ++rep) {
        pg8::Gemm g{(const pg8::bf16_t*)(ws + WS_HX), (const pg8::bf16_t*)(ws + WS_WIN), MA, NIN, DM}; pg8::InProjOrder S{M / 256, NIN / 256, MC / 256, 2, F.G, cb};
        pg8::EpiBf16<0> E{(pg8::bf16_t*)(ws + WS_QKV), NIN, 0, 0, 1.0f};
        pg8::gemm_phase<pg8::EpiBf16<0>, pg8::InProjOrder, true, false, false>(ring, g, S, E, nullptr);
        if (BOTH(2) || rep + 1 < NREP(2)) GRID_BAR(); }
    if (IN(3)) for (int rep = 0; rep < NREP(3); ++rep) { p3_qkv_post(F, args); if (BOTH(3) || rep + 1 < NREP(3)) GRID_BAR(); }
    if (IN(4)) for (int rep = 0; rep < NREP(4); ++rep) {
        const attn_body::AttnTensors AT{(const attn_body::bf16*)(ws + WS_Q), (const attn_body::bf16*)(ws + WS_KALL), (const attn_body::bf16*)(ws + WS_VALL), (attn_body::bf16*)(ws + WS_AC)};
        const attn_body::StaticOrder S((int)F.G, cb);
        attn_body::attn_phase<8>((char*)lds + RING_OFF, AT, S);
        if (BOTH(4) || rep + 1 < NREP(4)) GRID_BAR(); }
    if (IN(5)) for (int rep = 0; rep < NREP(5); ++rep) {
        pg8::Gemm g{(const pg8::bf16_t*)(ws + WS_AC), (const pg8::bf16_t*)(ws + WS_WOUT), M, DM, DM}; pg8::GridOrder S{M / 256, DM / 256, F.G, cb};
        pg8::EpiBf16<0> E{(pg8::bf16_t*)(ws + WS_Y), DM, 0, 0, 1.0f};
        pg8::gemm_phase<pg8::EpiBf16<0>, pg8::GridOrder, true, false, false>(ring, g, S, E, nullptr);
        if (BOTH(5) || rep + 1 < NREP(5)) GRID_BAR(); }
    if (IN(6)) for (int rep = 0; rep < NREP(6); ++rep) { rows_update<false>(F, args, args.in[0], (const bf16*)(ws + WS_Y), 0, 2, args.in[7], 0, 3, 4, args.in[13], (bf16*)(ws + WS_H2)); if (BOTH(6) || rep + 1 < NREP(6)) GRID_BAR(); }
    if (IN(7)) for (int rep = 0; rep < NREP(7); ++rep) {
        pg8::Gemm g{(const pg8::bf16_t*)(ws + WS_H2), (const pg8::bf16_t*)(ws + WS_WGU), M, 2 * DFF, DM}; pg8::GridOrder S{M / 256, 2 * DFF / 256, F.G, cb};
        pg8::EpiSwiGLU E{(pg8::bf16_t*)(ws + WS_HID), DFF, 0, 0};
        pg8::gemm_phase<pg8::EpiSwiGLU, pg8::GridOrder, true, false, false>(ring, g, S, E, nullptr);
        if (BOTH(7) || rep + 1 < NREP(7)) GRID_BAR(); }
    if (IN(8)) for (int rep = 0; rep < NREP(8); ++rep) {
        pg8::Gemm g{(const pg8::bf16_t*)(ws + WS_HID), (const pg8::bf16_t*)(ws + WS_WD), M, DM, DFF}; pg8::GridOrder S{M / 256, DM / 256, F.G, cb};
        pg8::EpiBf16<0> E{(pg8::bf16_t*)(ws + WS_Y), DM, 0, 0, 1.0f};
        pg8::gemm_phase<pg8::EpiBf16<0>, pg8::GridOrder, true, false, false>(ring, g, S, E, nullptr);
        if (BOTH(8) || rep + 1 < NREP(8)) GRID_BAR(); }
    if (IN(9)) for (int rep = 0; rep < NREP(9); ++rep) { rows_update<false>(F, args, args.out, (const bf16*)(ws + WS_Y), 0, 5, args.in[14], 1, 0, 1, args.in[20], (bf16*)(ws + WS_H2)); if (BOTH(9) || rep + 1 < NREP(9)) GRID_BAR(); }
    if (IN(10)) for (int rep = 0; rep < NREP(10); ++rep) {
        { pg8::Gemm g{(const pg8::bf16_t*)(ws + WS_H2), (const pg8::bf16_t*)(ws + WS_WGIN), M, DM, DM}; pg8::GridOrder S{M / 256, DM / 256, F.G, cb};
          pg8::EpiBf16<1> E{(pg8::bf16_t*)(ws + WS_U), DM, 0, 0, 1.0f};
          pg8::gemm_phase<pg8::EpiBf16<1>, pg8::GridOrder, true, false, false>(ring, g, S, E, nullptr); }
        { pg8::Gemm g{(const pg8::bf16_t*)(ws + WS_H2), (const pg8::bf16_t*)(ws + WS_WGIN) + (size_t)DM * DM, M, DM, DM}; pg8::GridOrder S{M / 256, DM / 256, F.G, cb};
          pg8::EpiGeluT E{(pg8::bf16_t*)(ws + WS_VT), DM};
          pg8::gemm_phase<pg8::EpiGeluT, pg8::GridOrder, true, true, false>(ring, g, S, E, nullptr); }
        if (BOTH(10) || rep + 1 < NREP(10)) GRID_BAR(); }
    if (IN(11)) for (int rep = 0; rep < NREP(11); ++rep) { p11_spatial(F, args); if (BOTH(11) || rep + 1 < NREP(11)) GRID_BAR(); }
    if (IN(12)) for (int rep = 0; rep < NREP(12); ++rep) {
        pg8::Gemm g{(const pg8::bf16_t*)(ws + WS_GM), (const pg8::bf16_t*)(ws + WS_WGOUT), M, DM, DM}; pg8::GridOrder S{M / 256, DM / 256, F.G, cb};
        pg8::EpiBf16<0> E{(pg8::bf16_t*)(ws + WS_Y), DM, 0, 0, 1.0f};
        pg8::gemm_phase<pg8::EpiBf16<0>, pg8::GridOrder, true, false, false>(ring, g, S, E, nullptr);
        if (BOTH(12) || rep + 1 < NREP(12)) GRID_BAR(); }
    if (IN(13)) for (int rep = 0; rep < NREP(13); ++rep) { rows_update<true>(F, args, args.out, (const bf16*)(ws + WS_Y), 1, 2, args.in[21], 1, 3, 4, args.in[28], (bf16*)(ws + WS_H4)); if (BOTH(13) || rep + 1 < NREP(13)) GRID_BAR(); }
    if (IN(14)) {
        moe_tables(F);
        const PG8_LAS int* mt = (const PG8_LAS int*)(F.lds + MOE_OFF); PG8_LAS int* idx = (PG8_LAS int*)(F.lds + IDX_OFF);
        const int T = mt[24]; const int* perm = (const int*)(ws + WS_PERM);
#pragma unroll 1
        for (int rep = 0; rep < NREP(14); ++rep) {
#if !defined(MOE_ONLY) || MOE_ONLY == 1
#pragma unroll 1
            for (int ib = 0; ; ib += IDX_UNITS - 1) {
                pg8::MoeOrder S{T, 2 * EFF / 256, F.G, cb, 0, mt + 32, ib, IDX_UNITS - 1};
                { pg8::Unit u0; if (!S.next(0, u0)) break; }
                for (int i = 0; i < IDX_UNITS - 1; ++i) { pg8::Unit u; if (!S.next(i, u)) break;
                    if (F.tid < 256) { const int tl = u.pm, e = mt[32 + tl], cn = mt[e]; int rank = (tl - mt[8 + e]) * 256 + F.tid; if (rank >= cn) rank = cn - 1; idx[i * 256 + F.tid] = perm[(size_t)e * M + rank]; } }
                __syncthreads();
                pg8::Gemm g{(const pg8::bf16_t*)(ws + WS_H4), (const pg8::bf16_t*)(ws + WS_WEGU), M, 2 * EFF, DM};
                pg8::EpiSwiGLU8 E{ws + WS_HIDE, EFF, 2 * EFF / 256, 0, 1.0f / (W_SCALE * H4_SCALE), HID_SCALE};
                pg8::gemm_phase<pg8::EpiSwiGLU8, pg8::MoeOrder, true, false, true, true>(ring, g, S, E, idx);
            }
#endif
            GRID_BAR();
#if !defined(MOE_ONLY) || MOE_ONLY == 2
            { pg8::MoeOrder S{T, DM / 256, F.G, cb, 0, mt + 32, 0, 1 << 20};
              pg8::Gemm g{(const pg8::bf16_t*)(ws + WS_HIDE), (const pg8::bf16_t*)(ws + WS_WED), TMAX * 256, DM, EFF};
              pg8::EpiBf16<0> E{(pg8::bf16_t*)(ws + WS_OSL), DM, DM / 256, 0, 1.0f / (W_SCALE * HID_SCALE)};
              pg8::gemm_phase<pg8::EpiBf16<0>, pg8::MoeOrder, true, false, false, true>(ring, g, S, E, nullptr); }
#endif
            GRID_BAR();
        }
    }
    if (IN(15)) { if (!IN(14)) moe_tables(F); p15_final(F, args); }
#undef IN
#undef BOTH
#undef GRID_BAR
}

extern "C" void kernel_launch(void* const* d_in, const int* in_sizes, int n_in, void* d_out, int out_size, void* d_ws, size_t ws_size, hipStream_t stream) {
    static int grid = 0;
    if (grid == 0) {
        if (n_in != 35 || in_sizes[0] != M * DM || out_size != M * DM || ws_size < WS_END) { fprintf(stderr, "kernel_launch: unexpected shapes / workspace (%d inputs, ws %zu, need %zu); nothing launched\n", n_in, ws_size, (size_t)WS_END); grid = -1; return; }
        int dev = 0, cus = 0;
        if (hipGetDevice(&dev) != hipSuccess || hipDeviceGetAttribute(&cus, hipDeviceAttributeMultiprocessorCount, dev) != hipSuccess) { grid = -1; return; }
        if (hipFuncSetAttribute((const void*)mk_fwd, hipFuncAttributeMaxDynamicSharedMemorySize, LDS_BYTES) != hipSuccess) { fprintf(stderr, "kernel_launch: hipFuncSetAttribute failed\n"); grid = -1; return; }
        int per_cu = 0;
        if (hipOccupancyMaxActiveBlocksPerMultiprocessor(&per_cu, (const void*)mk_fwd, NWAVES * 64, LDS_BYTES) != hipSuccess || per_cu < 1) fprintf(stderr, "kernel_launch: note: occupancy query reports %d workgroups per CU\n", per_cu);
        (void)hipGetLastError();
        grid = cus;
    }
    if (grid < 0) return;
    if (hipMemsetAsync((char*)d_ws + WS_CTL, 0, CTL_ZERO_BYTES, stream) != hipSuccess) return;
    Args a{};
    for (int i = 0; i < 35; ++i) a.in[i] = (const float*)d_in[i];
    a.out = (float*)d_out; a.ws = (unsigned char*)d_ws;
#if MK_PER_PHASE
    for (int p = 0; p < N_PHASES; ++p) { a.ph_lo = p; a.ph_hi = p + 1; hipLaunchKernelGGL(mk_fwd, dim3(grid), dim3(NWAVES * 64), LDS_BYTES, stream, a); }
#else
    a.ph_lo = 0; a.ph_hi = N_PHASES;
    hipLaunchKernelGGL(mk_fwd, dim3(grid), dim3(NWAVES * 64), LDS_BYTES, stream, a);
#endif
}
```
